# Optimizing an MI355X kernel written in HIP

```python
import jax, jax.numpy as jnp
from jax import lax
import numpy as np

D_MODEL = 1024
BATCH = 16
SEQ = 2048
DEPTH = 1
DEC_BATCH = 128
DEC_SEQ = 8
PAST_LEN = 8192
PAGE_SIZE = 128

HEAD_DIM = 64
N_ATT_HEADS = 8
N_KV_HEADS = 4
Q_PER_KV = N_ATT_HEADS // N_KV_HEADS
D_ATT = N_ATT_HEADS * HEAD_DIM
D_KV = N_KV_HEADS * HEAD_DIM
ROT_DIM = HEAD_DIM // 4
ROPE_THETA = 500000.0
DILATED_GROUPS = ((128, 1), (512, 4), (2048, 16))
MAX_WINDOW = max(w for w, _ in DILATED_GROUPS)
ATT_BLOCK = 128
ATT_SCALE = HEAD_DIM ** -0.5
NEG_BIG = -1e30
SSM_HEAD_DIM = 64
N_SSM_HEADS = 8
D_SSM = N_SSM_HEADS * SSM_HEAD_DIM
SSM_GROUPS = 2
HEADS_PER_SSM_GROUP = N_SSM_HEADS // SSM_GROUPS
D_STATE = 128
CONV_WIDTH = 4
SSD_CHUNK = 128
D_XBC = D_SSM + 2 * SSM_GROUPS * D_STATE
D_MIX = D_ATT + D_SSM
IN_SPLITS = (D_ATT, D_ATT + D_KV, D_ATT + 2 * D_KV, D_ATT + 2 * D_KV + D_SSM,
             D_ATT + 2 * D_KV + D_SSM + D_XBC)
D_IN_PROJ = D_ATT + 2 * D_KV + D_SSM + D_XBC + N_SSM_HEADS
D_FF = 4 * D_MODEL
RMS_EPS = 1e-5

kernel_name = "hymba_dilated_ssd_decoder_step"


def rmsnorm(x, g):
    xf = x.astype(jnp.float32)
    xf = xf * lax.rsqrt(jnp.mean(xf * xf, axis=-1, keepdims=True) + RMS_EPS)
    return xf.astype(x.dtype) * g


def rope(x, pos):
    half = ROT_DIM // 2
    inv = ROPE_THETA ** (-jnp.arange(0, ROT_DIM, 2, dtype=jnp.float32) / ROT_DIM)
    ang = pos.astype(jnp.float32)[:, None] * inv[None, :]
    shp = (ang.shape[0],) + (1,) * (x.ndim - 3) + (half,)
    cos, sin = jnp.cos(ang).reshape(shp), jnp.sin(ang).reshape(shp)
    x1 = x[..., :half].astype(jnp.float32)
    x2 = x[..., half:ROT_DIM].astype(jnp.float32)
    rot = jnp.concatenate([x1 * cos - x2 * sin, x2 * cos + x1 * sin], axis=-1)
    return jnp.concatenate([rot.astype(x.dtype), x[..., ROT_DIM:]], axis=-1)


def in_proj(h, pos, norm_mix, w_in):
    u = rmsnorm(h, norm_mix) @ w_in
    q, k, v, z, xbc, dt_raw = jnp.split(u, IN_SPLITS, axis=-1)
    b, s = h.shape[:2]
    q = rope(q.reshape(b, s, N_KV_HEADS, Q_PER_KV, HEAD_DIM), pos) * ATT_SCALE
    k = rope(k.reshape(b, s, N_KV_HEADS, HEAD_DIM), pos)
    v = v.reshape(b, s, N_KV_HEADS, HEAD_DIM)
    return q, k, v, z, xbc, dt_raw


def dilated_group_prompt(q, k, v, dilation, n_keys):
    b, s = q.shape[:2]
    L = s // dilation
    nb = -(-L // ATT_BLOCK)
    Lp = nb * ATT_BLOCK

    def to_sub(t):
        rest = t.shape[2:]
        t = t.reshape((b, L, dilation) + rest)
        t = jnp.swapaxes(t, 1, 2).reshape((b * dilation, L) + rest)
        t = jnp.pad(t, ((0, 0), (0, Lp - L)) + ((0, 0),) * len(rest))
        return t.reshape((b * dilation, nb, ATT_BLOCK) + rest)

    def band(t):
        prev = jnp.pad(t[:, :-1], ((0, 0), (1, 0)) + ((0, 0),) * (t.ndim - 2))
        return jnp.concatenate([prev, t], axis=2)

    qs = to_sub(q)
    kb, vb = band(to_sub(k)), band(to_sub(v))
    scores = jnp.einsum('znikgd,znjkd->znkgij', qs, kb, preferred_element_type=jnp.float32)
    i = jnp.arange(ATT_BLOCK)[:, None]
    j = jnp.arange(2 * ATT_BLOCK)[None, :]
    dist = i + ATT_BLOCK - j
    key_sub = jnp.arange(nb)[:, None, None] * ATT_BLOCK - ATT_BLOCK + j[None]
    mask = (dist >= 0)[None] & (dist <= n_keys)[None] & (key_sub >= 0)
    scores = jnp.where(mask[None, :, None, None], scores, NEG_BIG)
    lse = jax.nn.logsumexp(scores, axis=-1)
    p = jnp.exp(scores - lse[..., None])
    o = jnp.einsum('znkgij,znjkd->znikgd', p.astype(vb.dtype), vb)
    lse = jnp.moveaxis(lse, -1, 2)

    def from_sub(t):
        rest = t.shape[3:]
        t = t.reshape((b, dilation, Lp) + rest)[:, :, :L]
        return jnp.swapaxes(t, 1, 2).reshape((b, s) + rest)

    return from_sub(o), from_sub(lse)


def dilated_group_sample(q, k_ext, v_ext, dilation, n_keys, n_past):
    t = q.shape[1]
    idx = n_past + jnp.arange(t)[:, None] - dilation * jnp.arange(n_keys + 1)[None, :]
    valid = idx >= 0
    idx = jnp.maximum(idx, 0)
    kg, vg = k_ext[:, idx], v_ext[:, idx]
    scores = jnp.einsum('btkgd,btjkd->btkgj', q, kg, preferred_element_type=jnp.float32)
    scores = jnp.where(valid[None, :, None, None, :], scores, NEG_BIG)
    lse = jax.nn.logsumexp(scores, axis=-1)
    p = jnp.exp(scores - lse[..., None])
    o = jnp.einsum('btkgj,btjkd->btkgd', p.astype(vg.dtype), vg)
    return o, lse


def combine_groups(groups):
    o = jnp.stack([g[0] for g in groups]).astype(jnp.float32)
    lse = jnp.stack([g[1] for g in groups])
    w = jax.nn.softmax(lse, axis=0)
    return jnp.sum(w[..., None] * o, axis=0)


def causal_conv(xbc, prefix, conv_w, conv_b):
    s = xbc.shape[1]
    ext = jnp.concatenate([prefix.astype(xbc.dtype), xbc], axis=1)
    y = conv_b
    for tap in range(CONV_WIDTH):
        y = y + ext[:, tap:tap + s] * conv_w[tap]
    return jax.nn.silu(y), ext[:, s:]


def ssd_chunked(x, dt, A, Bm, Cm, h0):
    f32 = jnp.float32
    x, Bm, Cm, h0 = x.astype(f32), Bm.astype(f32), Cm.astype(f32), h0.astype(f32)
    b, s, h, p = x.shape
    q = min(SSD_CHUNK, s)
    nc = -(-s // q)
    pad = nc * q - s

    def chunks(t):
        t = jnp.pad(t, ((0, 0), (0, pad)) + ((0, 0),) * (t.ndim - 2))
        return t.reshape((b, nc, q) + t.shape[2:])

    x, dt, Bm, Cm = chunks(x), chunks(dt), chunks(Bm), chunks(Cm)
    a_cum = jnp.cumsum(dt * A, axis=2)
    causal = jnp.tril(jnp.ones((q, q), dtype=bool))
    seg = a_cum[:, :, :, None, :] - a_cum[:, :, None, :, :]
    decay = jnp.exp(jnp.where(causal[:, :, None], seg, -jnp.inf))
    cb = jnp.einsum('bcihn,bcjhn->bcijh', Cm, Bm)
    y_diag = jnp.einsum('bcijh,bcjhp->bcihp', cb * decay * dt[:, :, None], x)
    to_end = jnp.exp(a_cum[:, :, -1:] - a_cum) * dt
    chunk_states = jnp.einsum('bcjhn,bcjh,bcjhp->bchpn', Bm, to_end, x)
    chunk_decay = jnp.exp(a_cum[:, :, -1])

    def step(hc, inp):
        dec, st = inp
        return dec[:, :, None, None] * hc + st, hc

    h_final, h_prev = lax.scan(step, h0, (jnp.moveaxis(chunk_decay, 1, 0),
                                          jnp.moveaxis(chunk_states, 1, 0)))
    h_prev = jnp.moveaxis(h_prev, 0, 1)
    y_off = jnp.einsum('bcihn,bchpn,bcih->bcihp', Cm, h_prev, jnp.exp(a_cum))
    y = (y_diag + y_off).reshape(b, nc * q, h, p)[:, :s]
    return y, h_final


def ssm_branch(z, xbc, dt_raw, conv_prefix, h0, conv_w, conv_b, dt_bias, a_log, d_skip, ssm_norm):
    b, s = z.shape[:2]
    xbc, conv_state = causal_conv(xbc, conv_prefix, conv_w, conv_b)
    xs = xbc[..., :D_SSM].reshape(b, s, N_SSM_HEADS, SSM_HEAD_DIM)
    Bm = xbc[..., D_SSM:D_SSM + SSM_GROUPS * D_STATE].reshape(b, s, SSM_GROUPS, D_STATE)
    Cm = xbc[..., D_SSM + SSM_GROUPS * D_STATE:].reshape(b, s, SSM_GROUPS, D_STATE)
    Bm = jnp.repeat(Bm, HEADS_PER_SSM_GROUP, axis=2)
    Cm = jnp.repeat(Cm, HEADS_PER_SSM_GROUP, axis=2)
    dt = jax.nn.softplus(dt_raw.astype(jnp.float32) + dt_bias.astype(jnp.float32))
    A = -jnp.exp(a_log.astype(jnp.float32))
    y, h_final = ssd_chunked(xs, dt, A, Bm, Cm, h0)
    y = y + d_skip.astype(jnp.float32)[:, None] * xs.astype(jnp.float32)
    y = y.reshape(b, s, D_SSM) * jax.nn.silu(z.astype(jnp.float32))
    yg = y.reshape(b, s, SSM_GROUPS, D_SSM // SSM_GROUPS)
    yg = yg * lax.rsqrt(jnp.mean(yg * yg, axis=-1, keepdims=True) + RMS_EPS)
    y = yg.reshape(b, s, D_SSM).astype(z.dtype) * ssm_norm
    return y, conv_state, h_final


def out_and_mlp(h, att, ssm, w_out, norm_mlp, w_up, w_down):
    h = h + jnp.concatenate([att, ssm], axis=-1) @ w_out
    u = jax.nn.relu(rmsnorm(h, norm_mlp) @ w_up)
    return h + (u * u) @ w_down


def layer_prompt(h, lw):
    w_in, w_out, conv_w, conv_b, dt_bias, a_log, d_skip, ssm_norm, norm_mix, norm_mlp, w_up, w_down = lw
    b, s = h.shape[:2]
    q, k, v, z, xbc, dt_raw = in_proj(h, jnp.arange(s), norm_mix, w_in)
    groups = [dilated_group_prompt(q, k, v, d, w // d) for (w, d) in DILATED_GROUPS]
    att = combine_groups(groups).reshape(b, s, D_ATT).astype(h.dtype)
    conv_prefix = jnp.zeros((b, CONV_WIDTH - 1, D_XBC), h.dtype)
    h0 = jnp.zeros((b, N_SSM_HEADS, SSM_HEAD_DIM, D_STATE), jnp.float32)
    ssm, conv_state, ssm_state = ssm_branch(z, xbc, dt_raw, conv_prefix, h0, conv_w, conv_b,
                                            dt_bias, a_log, d_skip, ssm_norm)
    h = out_and_mlp(h, att, ssm, w_out, norm_mlp, w_up, w_down)
    keep = min(MAX_WINDOW, s)
    return h, k[:, s - keep:], v[:, s - keep:], conv_state, ssm_state


def layer_sample(h, cache_k, cache_v, conv_prefix, h0, lw):
    w_in, w_out, conv_w, conv_b, dt_bias, a_log, d_skip, ssm_norm, norm_mix, norm_mlp, w_up, w_down = lw
    b, t = h.shape[:2]
    n_past = cache_k.shape[1]
    q, k, v, z, xbc, dt_raw = in_proj(h, PAST_LEN + jnp.arange(t), norm_mix, w_in)
    k_ext = jnp.concatenate([cache_k.astype(k.dtype), k], axis=1)
    v_ext = jnp.concatenate([cache_v.astype(v.dtype), v], axis=1)
    groups = [dilated_group_sample(q, k_ext, v_ext, d, w // d, n_past) for (w, d) in DILATED_GROUPS]
    att = combine_groups(groups).reshape(b, t, D_ATT).astype(h.dtype)
    ssm, conv_state, ssm_state = ssm_branch(z, xbc, dt_raw, conv_prefix, h0, conv_w, conv_b,
                                            dt_bias, a_log, d_skip, ssm_norm)
    h = out_and_mlp(h, att, ssm, w_out, norm_mlp, w_up, w_down)
    return h, k_ext[:, t:], v_ext[:, t:], conv_state, ssm_state


def setup_inputs(seed: int = 0) -> dict:
    key = jax.random.key(seed)
    ks = jax.random.split(key, 20)
    f32 = jnp.float32
    n_past = min(MAX_WINDOW, PAST_LEN)

    def nrm(k, shape, scale):
        return scale * jax.random.normal(k, shape, f32)

    dt0 = jnp.exp(jax.random.uniform(ks[10], (DEPTH, N_SSM_HEADS), f32,
                                     np.log(1e-3), np.log(1e-1)))
    return {
        "x_prompt": nrm(ks[0], (BATCH, SEQ, D_MODEL), 1.0),
        "x_sample": nrm(ks[1], (DEC_BATCH, DEC_SEQ, D_MODEL), 1.0),
        "cache_k": nrm(ks[2], (DEPTH, DEC_BATCH, n_past, N_KV_HEADS, HEAD_DIM), 1.0),
        "cache_v": nrm(ks[3], (DEPTH, DEC_BATCH, n_past, N_KV_HEADS, HEAD_DIM), 1.0),
        "state_conv": nrm(ks[4], (DEPTH, DEC_BATCH, CONV_WIDTH - 1, D_XBC), 1.0),
        "state_ssm": nrm(ks[5], (DEPTH, DEC_BATCH, N_SSM_HEADS, SSM_HEAD_DIM, D_STATE), 0.1),
        "w_in": nrm(ks[6], (DEPTH, D_MODEL, D_IN_PROJ), D_MODEL ** -0.5),
        "w_out": nrm(ks[7], (DEPTH, D_MIX, D_MODEL), D_MIX ** -0.5),
        "conv_w": nrm(ks[8], (DEPTH, CONV_WIDTH, D_XBC), CONV_WIDTH ** -0.5),
        "conv_b": nrm(ks[9], (DEPTH, D_XBC), 0.01),
        "dt_bias": dt0 + jnp.log(-jnp.expm1(-dt0)),
        "a_log": jnp.log(jax.random.uniform(ks[11], (DEPTH, N_SSM_HEADS), f32, 1.0, 16.0)),
        "d_skip": 1.0 + nrm(ks[12], (DEPTH, N_SSM_HEADS), 0.1),
        "ssm_norm": 1.0 + nrm(ks[13], (DEPTH, D_SSM), 0.01),
        "norm_mix": 1.0 + nrm(ks[14], (DEPTH, D_MODEL), 0.01),
        "norm_mlp": 1.0 + nrm(ks[15], (DEPTH, D_MODEL), 0.01),
        "w_up": nrm(ks[16], (DEPTH, D_MODEL, D_FF), D_MODEL ** -0.5),
        "w_down": nrm(ks[17], (DEPTH, D_FF, D_MODEL), D_FF ** -0.5),
        "norm_final": 1.0 + nrm(ks[18], (D_MODEL,), 0.01),
    }


def reference(x_prompt, x_sample, cache_k, cache_v, state_conv, state_ssm,
              w_in, w_out, conv_w, conv_b, dt_bias, a_log, d_skip, ssm_norm,
              norm_mix, norm_mlp, w_up, w_down, norm_final):
    hp, hs = x_prompt, x_sample
    kp, vp, cp, sp = [], [], [], []
    ksm, vsm, csm, ssm_s = [], [], [], []
    for l in range(DEPTH):
        lw = (w_in[l], w_out[l], conv_w[l], conv_b[l], dt_bias[l], a_log[l], d_skip[l],
              ssm_norm[l], norm_mix[l], norm_mlp[l], w_up[l], w_down[l])
        hp, k1, v1, c1, s1 = layer_prompt(hp, lw)
        hs, k2, v2, c2, s2 = layer_sample(hs, cache_k[l], cache_v[l], state_conv[l], state_ssm[l], lw)
        kp.append(k1); vp.append(v1); cp.append(c1); sp.append(s1)
        ksm.append(k2); vsm.append(v2); csm.append(c2); ssm_s.append(s2)
    y_prompt = rmsnorm(hp, norm_final)
    y_sample = rmsnorm(hs, norm_final)
    return (y_prompt, y_sample,
            jnp.stack(kp), jnp.stack(vp), jnp.stack(cp), jnp.stack(sp),
            jnp.stack(ksm), jnp.stack(vsm), jnp.stack(csm), jnp.stack(ssm_s))
```

```cpp
#include <hip/hip_runtime.h>
#include <hip/hip_cooperative_groups.h>
#include <cstdio>
#include <cstdint>
namespace cg = cooperative_groups;
namespace pg8 {
#define PG8_LAS __attribute__((address_space(3)))
typedef unsigned short bf16_t;
typedef short bf16x8 __attribute__((ext_vector_type(8)));
typedef float f32x4 __attribute__((ext_vector_type(4)));
typedef unsigned u32x4 __attribute__((ext_vector_type(4)));
constexpr int BM = 256, BK = 64, HALF = 128, HTB = HALF * BK * 2  , STAGE_BYTES = 8 * HTB, NXCD = 8, WGM = 8;

__host__ __device__ __forceinline__ int lds_byte(int r, int c) { const int st = (r >> 4) * 2 + (c >> 5), rr = r & 15, cc = c & 31, ob = rr * 64 + cc * 2; return st * 1024 + (ob ^ (((ob >> 9) & 1) << 5)); }
__host__ __device__ __forceinline__ void stage_rc(int b, int& R, int& C) { const int st = b / 1024, sb = b % 1024, swz = sb ^ (((sb >> 9) & 1) << 5); R = (st >> 1) * 16 + swz / 64; C = (st & 1) * 32 + (swz % 64) / 2; }
__host__ __device__ __forceinline__ int perm32(int rho) { const int n = rho >> 4, i = rho & 15; return 8 * (i >> 2) + 4 * n + (i & 3); }

struct Unit { int pm, pn, k0; };
struct Gemm { const bf16_t* A; const bf16_t* Bt; int M, N, K, ld; };

struct StaticOrder {
    int nM, nN, nwg, G, c;
    __host__ __device__ void init(int M, int N, int G_, int c_) { nM = M / BM; nN = N / BM; nwg = nM * nN; G = G_; c = c_; }
    __host__ __device__ bool next(int i, Unit& u) const {
        const long L = (long)i * G + c; if (L >= nwg) return false;
        int wgid = (int)L; { const int q = nwg / NXCD, r = nwg % NXCD, xcd = wgid % NXCD, off = wgid / NXCD; wgid = (xcd < r ? xcd * (q + 1) : r * (q + 1) + (xcd - r) * q) + off; }
        const int nig = WGM * nN, gid = wgid / nig, fm = gid * WGM, gsz = (nM - fm) < WGM ? (nM - fm) : WGM;
        u.pm = fm + ((wgid % nig) % gsz); u.pn = (wgid % nig) / gsz; u.k0 = 0; return true;
    }
    __device__ __forceinline__ void a_ready(const Unit&) const {}
    __device__ __forceinline__ void done(const Unit&) const {}
};
__device__ __forceinline__ unsigned cvt_pk_bf16(float lo, float hi) { unsigned r; asm volatile("v_cvt_pk_bf16_f32 %0, %1, %2" : "=v"(r) : "v"(lo), "v"(hi)); return r; }

template <class Epi, class Sched, bool ALIGN_EPI = false, bool SP2 = false>
__device__ __forceinline__ void gemm_phase(PG8_LAS unsigned char* lds, const Gemm g, const Sched& S, const Epi& E) {
    const int tid = threadIdx.x, wid = __builtin_amdgcn_readfirstlane(tid >> 6), lane = tid & 63, wr = wid >> 2, wc = wid & 3, fr = lane & 15, fq = lane >> 4;
    const int K = g.ld, nt = g.K / BK;
    unsigned voffA[2], voffB[2];
#pragma unroll
    for (int i = 0; i < 2; ++i) { int R, C; stage_rc(tid * 16 + i * 8192, R, C); const int Rb = Epi::PERM ? ((R & ~31) + perm32(R & 31)) : R;
        voffA[i] = (unsigned)(R * K + C) * 2u; voffB[i] = (unsigned)(Rb * K + C) * 2u; }
    const size_t kstep = (size_t)(BK * 2);
    const size_t hstep = (size_t)HALF * K * 2;
    const size_t tstep = 2 * hstep;
    const unsigned ldsw = (unsigned)wid * 1024u;
    const int aoff = lds_byte(wr * 64 + fr, fq * 8), boff = lds_byte(wc * 32 + fr, fq * 8);
#define PG8_SA(b, h) (((b) * 2 + (h)) * HTB)
#define PG8_SB(b, h) ((4 + (b) * 2 + (h)) * HTB)
#define PG8_STAGE(bufoff, gbase, voff) do { _Pragma("unroll") for (int _i = 0; _i < 2; ++_i) \
        __builtin_amdgcn_global_load_lds((const unsigned*)((const char*)(gbase) + (voff)[_i]), (PG8_LAS unsigned*)(lds + (bufoff) + ldsw + _i * 8192), 16, 0, 0); } while (0)
#define PG8_LDA(dst, b, h) do { _Pragma("unroll") for (int m = 0; m < 4; ++m) _Pragma("unroll") for (int k = 0; k < 2; ++k) dst[m][k] = *(const PG8_LAS bf16x8*)(lds + PG8_SA(b, h) + aoff + m * 2048 + k * 1024); } while (0)
#define PG8_LDB(dst, b, h) do { _Pragma("unroll") for (int n = 0; n < 2; ++n) _Pragma("unroll") for (int k = 0; k < 2; ++k) dst[n][k] = *(const PG8_LAS bf16x8*)(lds + PG8_SB(b, h) + boff + n * 2048 + k * 1024); } while (0)
#define PG8_MMA(ai, bj, At, Bt) do { __builtin_amdgcn_s_setprio(1); _Pragma("unroll") for (int m = 0; m < 4; ++m) _Pragma("unroll") for (int n = 0; n < 2; ++n) _Pragma("unroll") for (int k = 0; k < 2; ++k) \
        acc[ai][bj][m][n] = __builtin_amdgcn_mfma_f32_16x16x32_bf16(Bt[n][k], At[m][k], acc[ai][bj][m][n], 0, 0, 0); __builtin_amdgcn_s_setprio(0); } while (0)
#define PG8_WAIT_V(n) asm volatile("s_waitcnt vmcnt(" #n ")" ::: "memory")
#define PG8_WAIT_L(n) asm volatile("s_waitcnt lgkmcnt(" #n ")" ::: "memory")
#define PG8_BAR __builtin_amdgcn_s_barrier()
#define PG8_SCHED __builtin_amdgcn_sched_barrier(0)
    Unit cur, nxt; int ui = 0;
    if (!S.next(0, cur)) return;
    f32x4 acc[2][2][4][2];
#pragma unroll
    for (int a = 0; a < 2; ++a)
#pragma unroll
        for (int b = 0; b < 2; ++b)
#pragma unroll
            for (int m = 0; m < 4; ++m)
#pragma unroll
                for (int n = 0; n < 2; ++n) acc[a][b][m][n] = (f32x4){0.f, 0.f, 0.f, 0.f};
    bf16x8 At[4][2], B0[2][2], B1[2][2];
    const char* cA = (const char*)g.A + (size_t)cur.pm * tstep + (size_t)cur.k0 * 2; const char* cB = (const char*)g.Bt + (size_t)cur.pn * tstep + (size_t)cur.k0 * 2;
    S.a_ready(cur);
    if constexpr (SP2) {
        PG8_STAGE(PG8_SB(0, 0), cB, voffB); PG8_STAGE(PG8_SB(0, 1), cB + hstep, voffB); PG8_STAGE(PG8_SA(0, 0), cA, voffA); PG8_STAGE(PG8_SA(0, 1), cA + hstep, voffA);
        if (wr == 1) PG8_BAR;
        PG8_WAIT_V(2); PG8_BAR;
        PG8_STAGE(PG8_SB(1, 0), cB + kstep, voffB); PG8_STAGE(PG8_SA(1, 0), cA + kstep, voffA); PG8_STAGE(PG8_SB(1, 1), cB + hstep + kstep, voffB);
        PG8_WAIT_V(6); PG8_BAR;
    } else {
        PG8_STAGE(PG8_SB(0, 0), cB, voffB); PG8_STAGE(PG8_SA(0, 0), cA, voffA); PG8_STAGE(PG8_SB(0, 1), cB + hstep, voffB); PG8_STAGE(PG8_SA(0, 1), cA + hstep, voffA);
        if (wr == 1) PG8_BAR;
        PG8_WAIT_V(4); PG8_BAR;
        PG8_STAGE(PG8_SB(1, 0), cB + kstep, voffB); PG8_STAGE(PG8_SA(1, 0), cA + kstep, voffA); PG8_STAGE(PG8_SB(1, 1), cB + hstep + kstep, voffB);
        PG8_WAIT_V(6); PG8_BAR;
    }
    for (;;) {
        const bool has_next = S.next(ui + 1, nxt);
        const char* nA = has_next ? (const char*)g.A + (size_t)nxt.pm * tstep + (size_t)nxt.k0 * 2 : cA; const char* nB = has_next ? (const char*)g.Bt + (size_t)nxt.pn * tstep + (size_t)nxt.k0 * 2 : cB;
        for (int t = 0; t < nt; t += 2) {
            const bool last = (t == nt - 2);
            const char* a1 = cA + (size_t)(t + 1) * kstep;
            const char* a2 = last ? nA : cA + (size_t)(t + 2) * kstep; const char* b2 = last ? nB : cB + (size_t)(t + 2) * kstep;
            const char* a3 = a2 + kstep; const char* b3 = b2 + kstep;
            if (last && has_next) S.a_ready(nxt);
            if constexpr (SP2) {
            PG8_LDB(B0, 0, 0); PG8_LDB(B1, 0, 1); PG8_SCHED; PG8_LDA(At, 0, 0); PG8_STAGE(PG8_SA(1, 1), a1 + hstep, voffA);
            PG8_WAIT_V(8); PG8_WAIT_L(0); PG8_BAR; PG8_MMA(0, 0, At, B0); PG8_MMA(0, 1, At, B1); PG8_BAR; PG8_SCHED;
            PG8_LDA(At, 0, 1); PG8_STAGE(PG8_SB(0, 0), b2, voffB); PG8_STAGE(PG8_SB(0, 1), b2 + hstep, voffB); PG8_STAGE(PG8_SA(0, 0), a2, voffA);
            PG8_WAIT_V(8); PG8_WAIT_L(0); PG8_BAR; PG8_MMA(1, 0, At, B0); PG8_MMA(1, 1, At, B1); PG8_BAR; PG8_SCHED;
            PG8_LDB(B0, 1, 0); PG8_LDB(B1, 1, 1); PG8_SCHED; PG8_LDA(At, 1, 0); PG8_STAGE(PG8_SA(0, 1), a2 + hstep, voffA);
            PG8_WAIT_V(8); PG8_WAIT_L(0); PG8_BAR; PG8_MMA(0, 0, At, B0); PG8_MMA(0, 1, At, B1); PG8_BAR; PG8_SCHED;
            PG8_LDA(At, 1, 1); PG8_STAGE(PG8_SB(1, 0), b3, voffB); PG8_STAGE(PG8_SB(1, 1), b3 + hstep, voffB); PG8_STAGE(PG8_SA(1, 0), a3, voffA);
            PG8_WAIT_V(8); PG8_WAIT_L(0); PG8_BAR; PG8_MMA(1, 0, At, B0); PG8_MMA(1, 1, At, B1); PG8_BAR; PG8_SCHED;
            } else {
            PG8_LDB(B0, 0, 0); PG8_SCHED; PG8_LDA(At, 0, 0); PG8_STAGE(PG8_SA(1, 1), a1 + hstep, voffA);
            PG8_WAIT_L(8); PG8_BAR; PG8_WAIT_L(0); PG8_MMA(0, 0, At, B0); PG8_BAR; PG8_SCHED;
            PG8_LDB(B1, 0, 1); PG8_STAGE(PG8_SB(0, 0), b2, voffB);
            PG8_BAR; PG8_WAIT_L(0); PG8_MMA(0, 1, At, B1); PG8_BAR;
            PG8_LDA(At, 0, 1); PG8_STAGE(PG8_SA(0, 0), a2, voffA);
            PG8_BAR; PG8_WAIT_L(0); PG8_MMA(1, 0, At, B0); PG8_BAR; PG8_SCHED;
            PG8_STAGE(PG8_SB(0, 1), b2 + hstep, voffB);
            PG8_WAIT_V(6); PG8_BAR; PG8_MMA(1, 1, At, B1); PG8_BAR;
            PG8_LDB(B0, 1, 0); PG8_SCHED; PG8_LDA(At, 1, 0); PG8_STAGE(PG8_SA(0, 1), a2 + hstep, voffA);
            PG8_WAIT_L(8); PG8_BAR; PG8_WAIT_L(0); PG8_MMA(0, 0, At, B0); PG8_BAR; PG8_SCHED;
            PG8_LDB(B1, 1, 1); PG8_STAGE(PG8_SB(1, 0), b3, voffB);
            PG8_BAR; PG8_WAIT_L(0); PG8_MMA(0, 1, At, B1); PG8_BAR;
            PG8_LDA(At, 1, 1); PG8_STAGE(PG8_SA(1, 0), a3, voffA);
            PG8_BAR; PG8_WAIT_L(0); PG8_MMA(1, 0, At, B0); PG8_BAR; PG8_SCHED;
            PG8_STAGE(PG8_SB(1, 1), b3 + hstep, voffB);
            PG8_WAIT_V(6); PG8_BAR; PG8_MMA(1, 1, At, B1); PG8_BAR;
            }
        }
        if constexpr (ALIGN_EPI) { if (wr == 0) PG8_BAR; }
        if constexpr (!Epi::AFTER_DRAIN) { E(acc, cur, wr, wc, fr, fq); S.done(cur); }
        if (!has_next) break;
#pragma unroll
        for (int a = 0; a < 2; ++a)
#pragma unroll
            for (int b = 0; b < 2; ++b)
#pragma unroll
                for (int m = 0; m < 4; ++m)
#pragma unroll
                    for (int n = 0; n < 2; ++n) acc[a][b][m][n] = (f32x4){0.f, 0.f, 0.f, 0.f};
        cur = nxt; cA = nA; cB = nB; ++ui;
        if constexpr (ALIGN_EPI) { if (wr == 1) PG8_BAR; }
    }
    PG8_WAIT_V(0);
    if constexpr (!ALIGN_EPI) { if (wr == 0) PG8_BAR; }
    PG8_BAR;
    if constexpr (Epi::AFTER_DRAIN) { E.fused(acc, cur, wr, wc, fr, fq, lds, wid, lane); S.done(cur); }
#undef PG8_SA
#undef PG8_SB
#undef PG8_STAGE
#undef PG8_LDA
#undef PG8_LDB
#undef PG8_MMA
#undef PG8_WAIT_V
#undef PG8_WAIT_L
#undef PG8_BAR
#undef PG8_SCHED
}
}

#ifndef HY_MASK
#define HY_MASK 255
#endif
#ifndef HY_P2MASK
#define HY_P2MASK 15
#endif
#ifndef HY_T1
#define HY_T1 1
#endif
#ifndef HY_T2
#define HY_T2 1
#endif
#ifndef HY_T3
#define HY_T3 1
#endif
#ifndef HY_DUP
#define HY_DUP -1
#endif
#ifndef HY_DLO
#define HY_DLO 0
#define HY_DHI (1 << 30)
#endif
#ifndef HY_N_LAUNCHES
#define HY_N_LAUNCHES 1
#endif
namespace hy {
#define LAS __attribute__((address_space(3)))
using pg8::bf16_t; using pg8::bf16x8; using pg8::f32x4; using pg8::u32x4; using pg8::Unit;
typedef float f32x16 __attribute__((ext_vector_type(16)));
typedef unsigned u32x2 __attribute__((ext_vector_type(2)));

constexpr int MP = 32768, MS = 1024, M = MP + MS, D = 1024, NU = 2560, NIN = 2568, FF = 4096;
constexpr int SEQ = 2048, NBATCH = 16, DBATCH = 128, DSEQ = 8, WC = 2048;
constexpr float EPS = 1e-5f;
constexpr size_t O_YP = 0, O_YS = O_YP + (size_t)MP * D, O_KP = O_YS + (size_t)MS * D, O_VP = O_KP + (size_t)MP * 256,
                 O_CP = O_VP + (size_t)MP * 256, O_SP = O_CP + (size_t)NBATCH * 3 * 1024, O_KS = O_SP + (size_t)NBATCH * 8 * 64 * 128,
                 O_VS = O_KS + (size_t)DBATCH * WC * 256, O_CS = O_VS + (size_t)DBATCH * WC * 256, O_SS = O_CS + (size_t)DBATCH * 3 * 1024,
                 O_END = O_SS + (size_t)DBATCH * 8 * 64 * 128;
constexpr size_t MiB = 1u << 20;
constexpr size_t WS_CTL = 0, CTL_BYTES = 1 * MiB;
constexpr size_t WS_WIN = 1 * MiB, WS_WOUT = 6 * MiB, WS_WUP = 8 * MiB, WS_WDN = 16 * MiB, WS_ROPE = 24 * MiB, WS_DT = 25 * MiB, WS_LSE = 27 * MiB;
constexpr size_t WS_XN = 32 * MiB, WS_U = 98 * MiB, WS_PO = 263 * MiB, WS_Y = 362 * MiB, WS_MIX = 395 * MiB, WS_H = 461 * MiB, WS_END = 725 * MiB;
constexpr int LDS_BYTES = 135168;
constexpr int MISC_OFF = 131072;

struct Params {
    const float *x_prompt, *x_sample, *cache_k, *cache_v, *state_conv, *state_ssm, *w_in, *w_out, *conv_w, *conv_b, *dt_bias, *a_log, *d_skip, *ssm_norm,
                *norm_mix, *norm_mlp, *w_up, *w_down, *norm_final;
    float* out; unsigned char* ws; int ph_lo, ph_hi;
};

__device__ __forceinline__ unsigned f2bf(float f) { unsigned u = __float_as_uint(f); return (u + 0x7fffu + ((u >> 16) & 1u)) >> 16; }
__device__ __forceinline__ unsigned pk2(float lo, float hi) { return f2bf(lo) | (f2bf(hi) << 16); }
__device__ __forceinline__ float bf2f(unsigned b) { return __uint_as_float(b << 16); }
__device__ __forceinline__ float bflo(unsigned w) { return __uint_as_float(w << 16); }
__device__ __forceinline__ float bfhi(unsigned w) { return __uint_as_float(w & 0xffff0000u); }
__device__ __forceinline__ float wave_sum(float v) {
#pragma unroll
    for (int o = 1; o < 64; o <<= 1) v += __shfl_xor(v, o);
    return v;
}
__device__ __forceinline__ float silu(float v) { return v * __builtin_amdgcn_rcpf(1.f + __expf(-v)); }
__device__ __forceinline__ float softplus(float v) { return v > 20.f ? v : log1pf(__expf(v)); }
#define MFMA32(a, b, c) __builtin_amdgcn_mfma_f32_32x32x16_bf16((a), (b), (c), 0, 0, 0)
__device__ __forceinline__ int crow(int r, int hh) { return (r & 3) + 8 * (r >> 2) + 4 * hh; }
__device__ __forceinline__ bf16x8 pack8(const f32x16& X, int s) {
    u32x4 w; w.x = pk2(X[8 * s + 0], X[8 * s + 1]); w.y = pk2(X[8 * s + 2], X[8 * s + 3]); w.z = pk2(X[8 * s + 4], X[8 * s + 5]); w.w = pk2(X[8 * s + 6], X[8 * s + 7]);
    return __builtin_bit_cast(bf16x8, w);
}
__device__ __forceinline__ bf16x8 ld2x8(const LAS bf16_t* p0, const LAS bf16_t* p1) {
    u32x2 a = *(const LAS u32x2*)p0, b = *(const LAS u32x2*)p1; u32x4 w; w.x = a.x; w.y = a.y; w.z = b.x; w.w = b.y; return __builtin_bit_cast(bf16x8, w);
}

__device__ __forceinline__ void transpose_item(const float* W, int ldw, int K, bf16_t* WT, LAS float* scr, int kb, int nb, int lane) {
    const int k0 = 64 * kb, n0 = 32 * nb;
#pragma unroll 8
    for (int i = 0; i < 32; ++i) { const int kk = 2 * i + (lane >> 5); scr[kk * 33 + (lane & 31)] = W[(size_t)(k0 + kk) * ldw + n0 + (lane & 31)]; }
    asm volatile("s_waitcnt lgkmcnt(0)" ::: "memory");
    const int c = lane & 7;
#pragma unroll
    for (int j = 0; j < 4; ++j) { const int n = (lane >> 3) + 8 * j; const LAS float* s = scr + (8 * c) * 33 + n;
        u32x4 o; o.x = pk2(s[0 * 33], s[1 * 33]); o.y = pk2(s[2 * 33], s[3 * 33]); o.z = pk2(s[4 * 33], s[5 * 33]); o.w = pk2(s[6 * 33], s[7 * 33]);
        *(u32x4*)(WT + (size_t)(n0 + n) * K + k0 + 8 * c) = o; }
    asm volatile("s_waitcnt lgkmcnt(0)" ::: "memory");
}

__device__ __forceinline__ void phase0(const Params& p, LAS unsigned char* lds) {
    const int tid = threadIdx.x, lane = tid & 63, wave = tid >> 6;
    const int G = gridDim.x, gw = blockIdx.x * 8 + wave, NGW = G * 8;
    unsigned char* ws = p.ws;
    LAS float* swA = (LAS float*)(lds + 69632);
    LAS float* swB = swA + 4096;
    for (int i = tid; i < 8192; i += 512) { const int k = i >> 3, e = i & 7; const float v = p.w_in[(size_t)k * NIN + NU + e];
        const int pos = ((k >> 8) * 4 + (k & 3)) * 64 + ((k >> 2) & 63); if (e < 4) swA[pos * 4 + e] = v; else swB[pos * 4 + e - 4] = v; }
    { float* rope = (float*)(ws + WS_ROPE);
      for (int i = blockIdx.x * 512 + tid; i < 2056 * 8; i += G * 512) { const int pi = i >> 3, f = i & 7; const float pos = pi < 2048 ? (float)pi : (float)(8192 + pi - 2048);
          const float inv = powf(500000.0f, -(float)(2 * f) / 16.0f); const float ang = pos * inv; rope[pi * 16 + f] = (float)cos((double)ang); rope[pi * 16 + 8 + f] = (float)sin((double)ang); } }
    { LAS float* scr = (LAS float*)(lds + wave * 8704);
      constexpr int I_IN = 16 * 80, I_OUT = 16 * 32, I_UP = 16 * 128, I_DN = 64 * 32, NIT = I_IN + I_OUT + I_UP + I_DN;
      for (int it = gw; it < NIT; it += NGW) { int r = it;
          if (r < I_IN) { transpose_item(p.w_in, NIN, 1024, (bf16_t*)(ws + WS_WIN), scr, r / 80, r % 80, lane); continue; } r -= I_IN;
          if (r < I_OUT) { transpose_item(p.w_out, 1024, 1024, (bf16_t*)(ws + WS_WOUT), scr, r / 32, r % 32, lane); continue; } r -= I_OUT;
          if (r < I_UP) { transpose_item(p.w_up, 4096, 1024, (bf16_t*)(ws + WS_WUP), scr, r / 128, r % 128, lane); continue; } r -= I_UP;
          transpose_item(p.w_down, 1024, 4096, (bf16_t*)(ws + WS_WDN), scr, r / 32, r % 32, lane); } }
    __syncthreads();
    { bf16_t* XN = (bf16_t*)(ws + WS_XN); float* DT = (float*)(ws + WS_DT);
      for (int row = gw; row < M; row += NGW) {
          const float* xr = row < MP ? p.x_prompt + (size_t)row * D : p.x_sample + (size_t)(row - MP) * D;
          f32x4 v[4]; float s = 0.f;
#pragma unroll
          for (int j = 0; j < 4; ++j) { v[j] = ((const f32x4*)xr)[lane + 64 * j]; s += (v[j].x * v[j].x + v[j].y * v[j].y) + (v[j].z * v[j].z + v[j].w * v[j].w); }
          s = wave_sum(s); const float rstd = 1.0f / sqrtf(s * (1.0f / 1024.0f) + EPS);
          float d0 = 0.f, d1 = 0.f, d2 = 0.f, d3 = 0.f, d4 = 0.f, d5 = 0.f, d6 = 0.f, d7 = 0.f;
#pragma unroll
          for (int j = 0; j < 4; ++j) {
              const f32x4 g = ((const f32x4*)p.norm_mix)[lane + 64 * j];
              const f32x4 xn = v[j] * rstd * g;
              u32x2 o; o.x = pk2(xn.x, xn.y); o.y = pk2(xn.z, xn.w);
              *(u32x2*)(XN + (size_t)row * D + 4 * lane + 256 * j) = o;
#pragma unroll
              for (int e = 0; e < 4; ++e) { const int pos = (j * 4 + e) * 64 + lane; const f32x4 wa = *(const LAS f32x4*)(swA + pos * 4), wb = *(const LAS f32x4*)(swB + pos * 4);
                  const float xe = xn[e]; d0 += xe * wa.x; d1 += xe * wa.y; d2 += xe * wa.z; d3 += xe * wa.w; d4 += xe * wb.x; d5 += xe * wb.y; d6 += xe * wb.z; d7 += xe * wb.w; }
          }
          d0 = wave_sum(d0); d1 = wave_sum(d1); d2 = wave_sum(d2); d3 = wave_sum(d3); d4 = wave_sum(d4); d5 = wave_sum(d5); d6 = wave_sum(d6); d7 = wave_sum(d7);
          if (lane == 0) { *(f32x4*)(DT + (size_t)row * 8) = (f32x4){d0, d1, d2, d3}; *(f32x4*)(DT + (size_t)row * 8 + 4) = (f32x4){d4, d5, d6, d7}; }
      } }
}

struct EpiIn {
    static constexpr bool PERM = true, AFTER_DRAIN = false;
    bf16_t* U; float* out; const float* rope;
    __device__ __forceinline__ void operator()(const f32x4 (&acc)[2][2][4][2], const Unit& u, int wr, int wc, int fr, int fq) const {
        const int pn = u.pn;
#pragma unroll
        for (int ai = 0; ai < 2; ++ai)
#pragma unroll
            for (int m = 0; m < 4; ++m) {
                const int row = u.pm * 256 + ai * 128 + wr * 64 + m * 16 + fr;
                const bool isp = row < MP; const int rs = row - MP;
                const int pidx = isp ? (row & 2047) : (2048 + (rs & 7));
#pragma unroll
                for (int bj = 0; bj < 2; ++bj) {
                    const int c0 = pn * 256 + bj * 128 + wc * 32 + 8 * fq;
                    f32x4 v0 = acc[ai][bj][m][0], v1 = acc[ai][bj][m][1];
                    if (pn <= 2 && !(wc & 1)) {
                        f32x4 p0, p1;
                        p0.x = __shfl_xor(v0.x, 16); p0.y = __shfl_xor(v0.y, 16); p0.z = __shfl_xor(v0.z, 16); p0.w = __shfl_xor(v0.w, 16);
                        p1.x = __shfl_xor(v1.x, 16); p1.y = __shfl_xor(v1.y, 16); p1.z = __shfl_xor(v1.z, 16); p1.w = __shfl_xor(v1.w, 16);
                        if (fq < 2) {
                            const f32x4 c0v = *(const f32x4*)(rope + pidx * 16), c1v = *(const f32x4*)(rope + pidx * 16 + 4);
                            f32x4 s0v = *(const f32x4*)(rope + pidx * 16 + 8), s1v = *(const f32x4*)(rope + pidx * 16 + 12);
                            if (fq == 0) { s0v = -s0v; s1v = -s1v; }
                            v0 = v0 * c0v + p0 * s0v; v1 = v1 * c1v + p1 * s1v;
                        }
                    }
                    if (pn < 2) { v0 = v0 * 0.125f; v1 = v1 * 0.125f; }
                    u32x4 w; w.x = pk2(v0.x, v0.y); w.y = pk2(v0.z, v0.w); w.z = pk2(v1.x, v1.y); w.w = pk2(v1.z, v1.w);
                    *(u32x4*)(U + (size_t)row * NU + c0) = w;
                    if (pn == 2 || pn == 3) {
                        const size_t orow = isp ? (size_t)row : (size_t)((rs >> 3) * WC + 2040 + (rs & 7));
                        const size_t base = isp ? (pn == 2 ? O_KP : O_VP) : (pn == 2 ? O_KS : O_VS);
                        float* o = out + base + orow * 256 + (c0 - pn * 256);
                        *(f32x4*)o = v0; *(f32x4*)(o + 4) = v1;
                    }
                    if (pn >= 6) {
                        if (isp) { const int s = row & 2047; if (s >= 2045) { float* o = out + O_CP + (size_t)((row >> 11) * 3 + (s - 2045)) * 1024 + (c0 - 1536); *(f32x4*)o = v0; *(f32x4*)(o + 4) = v1; } }
                        else { const int t = rs & 7; if (t >= 5) { float* o = out + O_CS + (size_t)((rs >> 3) * 3 + (t - 5)) * 1024 + (c0 - 1536); *(f32x4*)o = v0; *(f32x4*)(o + 4) = v1; } }
                    }
                }
            }
    }
};
struct EpiOut {
    static constexpr bool PERM = true, AFTER_DRAIN = false;
    const float* xp; const float* xs; float* h1; bf16_t* HG; const float* gm; float* ssq; bf16_t* H1;
    __device__ __forceinline__ void operator()(const f32x4 (&acc)[2][2][4][2], const Unit& u, int wr, int wc, int fr, int fq) const {
#pragma unroll
        for (int ai = 0; ai < 2; ++ai)
#pragma unroll
            for (int m = 0; m < 4; ++m) {
                const int row = u.pm * 256 + ai * 128 + wr * 64 + m * 16 + fr;
                const float* xr = row < MP ? xp + (size_t)row * D : xs + (size_t)(row - MP) * D;
                float ss = 0.f;
#pragma unroll
                for (int bj = 0; bj < 2; ++bj) {
                    const int c0 = u.pn * 256 + bj * 128 + wc * 32 + 8 * fq;
                    const f32x4 a0 = *(const f32x4*)(xr + c0) + acc[ai][bj][m][0], a1 = *(const f32x4*)(xr + c0 + 4) + acc[ai][bj][m][1];
                    if (row >= MP) { *(f32x4*)(h1 + (size_t)row * D + c0) = a0; *(f32x4*)(h1 + (size_t)row * D + c0 + 4) = a1; }
                    else { u32x4 wh; wh.x = pk2(a0.x, a0.y); wh.y = pk2(a0.z, a0.w); wh.z = pk2(a1.x, a1.y); wh.w = pk2(a1.z, a1.w); *(u32x4*)(H1 + (size_t)row * D + c0) = wh; }
                    const f32x4 g0 = *(const f32x4*)(gm + c0), g1 = *(const f32x4*)(gm + c0 + 4);
                    u32x4 w; w.x = pk2(a0.x * g0.x, a0.y * g0.y); w.y = pk2(a0.z * g0.z, a0.w * g0.w); w.z = pk2(a1.x * g1.x, a1.y * g1.y); w.w = pk2(a1.z * g1.z, a1.w * g1.w);
                    *(u32x4*)(HG + (size_t)row * D + c0) = w;
                    ss += (a0.x * a0.x + a0.y * a0.y) + (a0.z * a0.z + a0.w * a0.w) + (a1.x * a1.x + a1.y * a1.y) + (a1.z * a1.z + a1.w * a1.w);
                }
                ss += __shfl_xor(ss, 16); ss += __shfl_xor(ss, 32);
                if (fq == 0) atomicAdd(ssq + row, ss);
            }
    }
};
struct EpiUp {
    static constexpr bool PERM = true, AFTER_DRAIN = false;
    const float* ssq; bf16_t* H;
    __device__ __forceinline__ void operator()(const f32x4 (&acc)[2][2][4][2], const Unit& u, int wr, int wc, int fr, int fq) const {
#pragma unroll
        for (int ai = 0; ai < 2; ++ai)
#pragma unroll
            for (int m = 0; m < 4; ++m) {
                const int row = u.pm * 256 + ai * 128 + wr * 64 + m * 16 + fr;
                const float rstd = 1.0f / sqrtf(ssq[row] * (1.0f / 1024.0f) + EPS);
#pragma unroll
                for (int bj = 0; bj < 2; ++bj) {
                    const int c0 = u.pn * 256 + bj * 128 + wc * 32 + 8 * fq;
                    f32x4 a0 = acc[ai][bj][m][0] * rstd, a1 = acc[ai][bj][m][1] * rstd;
                    a0.x = fmaxf(a0.x, 0.f); a0.y = fmaxf(a0.y, 0.f); a0.z = fmaxf(a0.z, 0.f); a0.w = fmaxf(a0.w, 0.f);
                    a1.x = fmaxf(a1.x, 0.f); a1.y = fmaxf(a1.y, 0.f); a1.z = fmaxf(a1.z, 0.f); a1.w = fmaxf(a1.w, 0.f);
                    a0 = a0 * a0; a1 = a1 * a1;
                    u32x4 w; w.x = pk2(a0.x, a0.y); w.y = pk2(a0.z, a0.w); w.z = pk2(a1.x, a1.y); w.w = pk2(a1.z, a1.w);
                    *(u32x4*)(H + (size_t)row * FF + c0) = w;
                }
            }
    }
};
struct EpiDown {
    static constexpr bool PERM = true, AFTER_DRAIN = false;
    const bf16_t* H1; bf16_t* H2;
    __device__ __forceinline__ void operator()(const f32x4 (&acc)[2][2][4][2], const Unit& u, int wr, int wc, int fr, int fq) const {
#pragma unroll
        for (int ai = 0; ai < 2; ++ai)
#pragma unroll
            for (int m = 0; m < 4; ++m) {
                const int row = u.pm * 256 + ai * 128 + wr * 64 + m * 16 + fr;
#pragma unroll
                for (int bj = 0; bj < 2; ++bj) {
                    const int c0 = u.pn * 256 + bj * 128 + wc * 32 + 8 * fq;
                    const u32x4 hq = *(const u32x4*)(H1 + (size_t)row * D + c0);
                    const f32x4 a0 = (f32x4){bflo(hq.x), bfhi(hq.x), bflo(hq.y), bfhi(hq.y)} + acc[ai][bj][m][0], a1 = (f32x4){bflo(hq.z), bfhi(hq.z), bflo(hq.w), bfhi(hq.w)} + acc[ai][bj][m][1];
                    u32x4 w; w.x = pk2(a0.x, a0.y); w.y = pk2(a0.z, a0.w); w.z = pk2(a1.x, a1.y); w.w = pk2(a1.z, a1.w);
                    *(u32x4*)(H2 + (size_t)row * D + c0) = w;
                }
            }
    }
};
struct EpiDownAtomic {
    static constexpr bool PERM = true, AFTER_DRAIN = false;
    float* part;
    __device__ __forceinline__ void operator()(const f32x4 (&acc)[2][2][4][2], const Unit& u, int wr, int wc, int fr, int fq) const {
        float* pb = part + (size_t)(u.k0 >> 10) * MS * D;
#pragma unroll
        for (int ai = 0; ai < 2; ++ai)
#pragma unroll
            for (int m = 0; m < 4; ++m) {
                const int row = u.pm * 256 + ai * 128 + wr * 64 + m * 16 + fr;
#pragma unroll
                for (int bj = 0; bj < 2; ++bj) {
                    const int c0 = u.pn * 256 + bj * 128 + wc * 32 + 8 * fq;
                    float* hp = pb + (size_t)row * D + c0;
                    *(f32x4*)hp = acc[ai][bj][m][0]; *(f32x4*)(hp + 4) = acc[ai][bj][m][1];
                }
            }
    }
};
struct SplitOrder {
    int G, c;
    __device__ bool next(int i, Unit& u) const { const int L = i * G + c; if (L >= 64) return false; const int kp = L >> 4, t = L & 15; u.pm = t >> 2; u.pn = t & 3; u.k0 = kp * 1024; return true; }
    __device__ __forceinline__ void a_ready(const Unit&) const {}
    __device__ __forceinline__ void done(const Unit&) const {}
};

constexpr int PB = 136;
__device__ __forceinline__ void ssd_prompt_unit(const Params& p, LAS unsigned char* lds, int b, int h) {
    const int tid = threadIdx.x, lane = tid & 63, w = __builtin_amdgcn_readfirstlane(tid >> 6), r32 = lane & 31, hh = lane >> 5;
    const int g = h >> 2;
    const bf16_t* U = (const bf16_t*)(p.ws + WS_U); const float* DT = (const float*)(p.ws + WS_DT); bf16_t* Y = (bf16_t*)(p.ws + WS_Y);
    LAS bf16_t* sB = (LAS bf16_t*)lds;
    LAS bf16_t* sC = sB + 128 * PB;
    LAS bf16_t* sXT = sC + 128 * PB;
    LAS bf16_t* sXW = sXT + 64 * PB;
    LAS bf16_t* sH = sXW + 64 * PB;
    LAS float* sA = (LAS float*)(sH + 64 * PB);
    LAS float* sDt = sA + 128;
    const float Ah = -__expf(p.a_log[h]), dtb = p.dt_bias[h], Dsk = p.d_skip[h];
    __syncthreads();
    for (int i = tid; i < 64 * PB / 2; i += 512) ((LAS unsigned*)sH)[i] = 0u;
    const int oct = tid % 40, tl = tid / 40;
    int ucol; if (oct < 8) ucol = 1536 + h * 64 + 8 * oct; else if (oct < 24) ucol = 2048 + g * 128 + 8 * (oct - 8); else ucol = 2304 + g * 128 + 8 * (oct - 24);
    LAS float* sCW = sDt + 128;
    for (int i = tid; i < 1600; i += 512) { const int oc = i / 40, k = i % 40;
        const int ch = (oc < 8) ? (h * 64 + 8 * oc) : (oc < 24) ? (512 + g * 128 + 8 * (oc - 8)) : (768 + g * 128 + 8 * (oc - 24));
        sCW[i] = (k < 32) ? p.conv_w[(k >> 3) * 1024 + ch + (k & 7)] : p.conv_b[ch + k - 32]; }
    __syncthreads();
    f32x16 hacc;
#pragma unroll
    for (int r = 0; r < 16; ++r) hacc[r] = 0.f;
    const int bi = w >> 1, pt = w & 1, nt = w >> 1;
    const int tb = tl * 11;
    u32x4 pw1, pw2, pw3, nx[4];
    pw1 = pw2 = pw3 = (u32x4){0u, 0u, 0u, 0u};
#pragma unroll
    for (int k = 0; k < 4; ++k) nx[k] = (u32x4){0u, 0u, 0u, 0u};
    if (tid < 480) {
        const bf16_t* upn = U + ((size_t)b * SEQ + tb) * NU + ucol;
        if (tb >= 3) { pw1 = *(const u32x4*)(upn - 3 * (ptrdiff_t)NU); pw2 = *(const u32x4*)(upn - 2 * (ptrdiff_t)NU); pw3 = *(const u32x4*)(upn - (ptrdiff_t)NU); }
#pragma unroll
        for (int k = 0; k < 4; ++k) if (tb + k < 128) nx[k] = *(const u32x4*)(upn + (size_t)k * NU);
    }
    float dtn = 0.f, dtn0 = 0.f;
    if (w < 2) { dtn = DT[((size_t)b * SEQ + 64 * w + lane) * 8 + h]; dtn0 = DT[((size_t)b * SEQ + lane) * 8 + h]; }
    for (int c = 0; c < 16; ++c) {
        const int t0 = c * 128; const size_t rowb = (size_t)b * SEQ + t0;
        if (w < 2) {
            const int t = 64 * w + lane;
            const float dtv = softplus(dtn + dtb);
            float sc = dtv * Ah;
#pragma unroll
            for (int o = 1; o < 64; o <<= 1) { const float n = __shfl_up(sc, o); if (lane >= o) sc += n; }
            if (w == 1) { const float d0 = softplus(dtn0 + dtb); sc += wave_sum(d0 * Ah); }
            sA[t] = sc; sDt[t] = dtv;
            if (c < 15) { dtn = DT[(rowb + 128 + t) * 8 + h]; dtn0 = DT[(rowb + 128 + lane) * 8 + h]; }
        }
        if (HY_T1 && tid < 480) {
            float cw[4][8], cb[8];
#pragma unroll
            for (int tp = 0; tp < 4; ++tp) { const f32x4 a = *(const LAS f32x4*)(sCW + oct * 40 + tp * 8), cc = *(const LAS f32x4*)(sCW + oct * 40 + tp * 8 + 4);
                cw[tp][0] = a.x; cw[tp][1] = a.y; cw[tp][2] = a.z; cw[tp][3] = a.w; cw[tp][4] = cc.x; cw[tp][5] = cc.y; cw[tp][6] = cc.z; cw[tp][7] = cc.w; }
            { const f32x4 a = *(const LAS f32x4*)(sCW + oct * 40 + 32), cc = *(const LAS f32x4*)(sCW + oct * 40 + 36);
              cb[0] = a.x; cb[1] = a.y; cb[2] = a.z; cb[3] = a.w; cb[4] = cc.x; cb[5] = cc.y; cb[6] = cc.z; cb[7] = cc.w; }
            u32x4 win[4];
            const bf16_t* up = U + ((size_t)b * SEQ + t0 + tb) * NU + ucol;
            win[1] = pw1; win[2] = pw2; win[3] = pw3;
#pragma unroll 1
            for (int i = 0; i < 11; ++i) {
                const int t = tb + i; if (t >= 128) break;
                win[0] = win[1]; win[1] = win[2]; win[2] = win[3]; win[3] = nx[0];
                nx[0] = nx[1]; nx[1] = nx[2]; nx[2] = nx[3];
                if (t + 4 < 128 && i + 4 < 11) nx[3] = *(const u32x4*)(up + (size_t)(i + 4) * NU);
                float o[8];
#pragma unroll
                for (int e = 0; e < 8; ++e) o[e] = cb[e];
#pragma unroll
                for (int tp = 0; tp < 4; ++tp) {
                    const u32x4 q = win[tp];
                    o[0] += cw[tp][0] * bflo(q.x); o[1] += cw[tp][1] * bfhi(q.x); o[2] += cw[tp][2] * bflo(q.y); o[3] += cw[tp][3] * bfhi(q.y);
                    o[4] += cw[tp][4] * bflo(q.z); o[5] += cw[tp][5] * bfhi(q.z); o[6] += cw[tp][6] * bflo(q.w); o[7] += cw[tp][7] * bfhi(q.w);
                }
#pragma unroll
                for (int e = 0; e < 8; ++e) o[e] = silu(o[e]);
                if (oct < 8) {
#pragma unroll
                    for (int e = 0; e < 8; ++e) sXT[(8 * oct + e) * PB + t] = (bf16_t)f2bf(o[e]);
                } else {
                    u32x4 wv; wv.x = pk2(o[0], o[1]); wv.y = pk2(o[2], o[3]); wv.z = pk2(o[4], o[5]); wv.w = pk2(o[6], o[7]);
                    LAS bf16_t* dst = (oct < 24) ? (sB + t * PB + 8 * (oct - 8)) : (sC + t * PB + 8 * (oct - 24));
                    *(LAS u32x4*)dst = wv;
                }
            }
        }
        __syncthreads();
        { const float aL = sA[127];
#pragma unroll
          for (int k = 0; k < 2; ++k) { const int idx = tid + 512 * k, pp = idx >> 4, to = (idx & 15) * 8;
              const u32x4 q = *(const LAS u32x4*)(sXT + pp * PB + to);
              float wgt[8];
#pragma unroll
              for (int e = 0; e < 8; ++e) wgt[e] = __expf(aL - sA[to + e]) * sDt[to + e];
              u32x4 o; o.x = pk2(bflo(q.x) * wgt[0], bfhi(q.x) * wgt[1]); o.y = pk2(bflo(q.y) * wgt[2], bfhi(q.y) * wgt[3]);
              o.z = pk2(bflo(q.z) * wgt[4], bfhi(q.z) * wgt[5]); o.w = pk2(bflo(q.w) * wgt[6], bfhi(q.w) * wgt[7]);
              *(LAS u32x4*)(sXW + pp * PB + to) = o; } }
        __syncthreads();
        if (tid < 480 && c < 15) {
            const bf16_t* upn = U + ((size_t)b * SEQ + t0 + 128 + tb) * NU + ucol;
            pw1 = *(const u32x4*)(upn - 3 * (ptrdiff_t)NU); pw2 = *(const u32x4*)(upn - 2 * (ptrdiff_t)NU); pw3 = *(const u32x4*)(upn - (ptrdiff_t)NU);
#pragma unroll
            for (int k = 0; k < 4; ++k) if (tb + k < 128) nx[k] = *(const u32x4*)(upn + (size_t)k * NU);
        }
        if (HY_T2) {
            f32x16 yd, yo;
#pragma unroll
            for (int r = 0; r < 16; ++r) { yd[r] = 0.f; yo[r] = 0.f; }
            const int icol = 32 * bi + r32; const float a_i = sA[icol];
            for (int bj = 0; bj <= bi; ++bj) {
                f32x16 X;
#pragma unroll
                for (int r = 0; r < 16; ++r) X[r] = 0.f;
#pragma unroll 4
                for (int s = 0; s < 8; ++s) {
                    const bf16x8 Af = *(const LAS bf16x8*)(sB + (32 * bj + r32) * PB + 16 * s + 8 * hh);
                    const bf16x8 Bf = *(const LAS bf16x8*)(sC + icol * PB + 16 * s + 8 * hh);
                    X = MFMA32(Af, Bf, X);
                }
#pragma unroll
                for (int r = 0; r < 16; ++r) { const int j = 32 * bj + crow(r, hh); const float f = __expf(a_i - sA[j]) * sDt[j]; X[r] = (j <= icol) ? X[r] * f : 0.f; }
#pragma unroll
                for (int s = 0; s < 2; ++s) {
                    const LAS bf16_t* xp_ = sXT + (32 * pt + r32) * PB + 32 * bj + 16 * s + 4 * hh;
                    const bf16x8 Af = ld2x8(xp_, xp_ + 8);
                    yd = MFMA32(Af, pack8(X, s), yd);
                }
            }
            u32x2 zz4[4];
#pragma unroll
            for (int q4 = 0; q4 < 4; ++q4) zz4[q4] = *(const u32x2*)(U + (rowb + icol) * NU + 1024 + h * 64 + 32 * pt + 8 * q4 + 4 * hh);
#pragma unroll 4
            for (int s = 0; s < 8; ++s) {
                const bf16x8 Af = *(const LAS bf16x8*)(sH + (32 * pt + r32) * PB + 16 * s + 8 * hh);
                const bf16x8 Bf = *(const LAS bf16x8*)(sC + icol * PB + 16 * s + 8 * hh);
                yo = MFMA32(Af, Bf, yo);
            }
            const float ea = __expf(a_i);
            const size_t row = rowb + icol;
#pragma unroll
            for (int q4 = 0; q4 < 4; ++q4) {
                const int p0 = 32 * pt + 8 * q4 + 4 * hh;
                const u32x2 zz = zz4[q4];
                float yv[4];
#pragma unroll
                for (int e = 0; e < 4; ++e) { const float xv = bf2f(sXT[(p0 + e) * PB + icol]); yv[e] = yd[4 * q4 + e] + ea * yo[4 * q4 + e] + Dsk * xv; }
                yv[0] *= silu(bflo(zz.x)); yv[1] *= silu(bfhi(zz.x)); yv[2] *= silu(bflo(zz.y)); yv[3] *= silu(bfhi(zz.y));
                u32x2 o; o.x = pk2(yv[0], yv[1]); o.y = pk2(yv[2], yv[3]);
                *(u32x2*)(Y + row * 512 + h * 64 + p0) = o;
            }
        }
        if (HY_T3) {
            const float dec = __expf(sA[127]);
#pragma unroll
            for (int r = 0; r < 16; ++r) hacc[r] *= dec;
#pragma unroll 2
            for (int s = 0; s < 8; ++s) {
                const bf16x8 Af = *(const LAS bf16x8*)(sXW + (32 * pt + r32) * PB + 16 * s + 8 * hh);
                const LAS bf16_t* bp = sB + (16 * s + 8 * hh) * PB + 32 * nt + r32;
                u32x4 wv; wv.x = (unsigned)bp[0] | ((unsigned)bp[PB] << 16); wv.y = (unsigned)bp[2 * PB] | ((unsigned)bp[3 * PB] << 16);
                wv.z = (unsigned)bp[4 * PB] | ((unsigned)bp[5 * PB] << 16); wv.w = (unsigned)bp[6 * PB] | ((unsigned)bp[7 * PB] << 16);
                hacc = MFMA32(Af, __builtin_bit_cast(bf16x8, wv), hacc);
            }
        }
        __syncthreads();
#pragma unroll
        for (int r = 0; r < 16; ++r) sH[(32 * pt + crow(r, hh)) * PB + 32 * nt + r32] = (bf16_t)f2bf(hacc[r]);
    }
    float* so = p.out + O_SP + (size_t)(b * 8 + h) * 64 * 128;
#pragma unroll
    for (int r = 0; r < 16; ++r) so[(32 * pt + crow(r, hh)) * 128 + 32 * nt + r32] = hacc[r];
}

constexpr int VP = 264, KP = 72;
__device__ __forceinline__ void attn_prompt_unit(const Params& p, LAS unsigned char* lds, int unit) {
    const int tid = threadIdx.x, lane = tid & 63, w = __builtin_amdgcn_readfirstlane(tid >> 6), r32 = lane & 31, hh = lane >> 5;
    const int g = unit >> 10, rr = unit & 1023, b = rr >> 6, r2 = rr & 63, kvh = r2 >> 4, zn = r2 & 15;
    const int dsh = 2 * g, d = 1 << dsh;
    const int nbl = 16 >> dsh;
    const int z = zn / nbl, n = zn % nbl;
    const bf16_t* U = (const bf16_t*)(p.ws + WS_U);
    bf16_t* PO = (bf16_t*)(p.ws + WS_PO) + (size_t)g * M * 512; float* LSE = (float*)(p.ws + WS_LSE) + (size_t)g * M * 8;
    LAS bf16_t* sK = (LAS bf16_t*)lds;
    LAS bf16_t* sVT = sK + 256 * KP;
    const size_t rowb = (size_t)b * SEQ;
    const int sub0 = 128 * (n - 1);
    __syncthreads();
#pragma unroll
    for (int k = 0; k < 4; ++k) {
        const int idx = tid + 512 * k, key = idx >> 3, oc = idx & 7;
        const int js = sub0 + key;
        u32x4 q = (u32x4){0u, 0u, 0u, 0u}, kq = q;
        if (js >= 0) { const bf16_t* rp = U + (rowb + z + (size_t)d * js) * NU + kvh * 64 + 8 * oc; kq = *(const u32x4*)(rp + 512); q = *(const u32x4*)(rp + 768); }
        *(LAS u32x4*)(sK + key * KP + 8 * oc) = kq;
        LAS bf16_t* dst = sVT + (8 * oc) * VP + (key ^ (oc << 2));
        dst[0] = (bf16_t)(q.x & 0xffffu); dst[VP] = (bf16_t)(q.x >> 16); dst[2 * VP] = (bf16_t)(q.y & 0xffffu); dst[3 * VP] = (bf16_t)(q.y >> 16);
        dst[4 * VP] = (bf16_t)(q.z & 0xffffu); dst[5 * VP] = (bf16_t)(q.z >> 16); dst[6 * VP] = (bf16_t)(q.w & 0xffffu); dst[7 * VP] = (bf16_t)(q.w >> 16);
    }
    const int w3 = w & 3, hq = kvh * 2 + (w >> 2);
    const int qsub = 128 * n + 32 * w3 + r32;
    const size_t qrow = rowb + z + (size_t)d * qsub;
    bf16x8 qf[4];
#pragma unroll
    for (int s = 0; s < 4; ++s) qf[s] = *(const bf16x8*)(U + qrow * NU + hq * 64 + 16 * s + 8 * hh);
    __syncthreads();
    f32x16 S[5];
    const int iq = 128 + 32 * w3 + r32;
#pragma unroll
    for (int kk = 0; kk < 5; ++kk) {
        const int kb = w3 + kk;
        const bool live = (n > 0) || (kb >= 4);
#pragma unroll
        for (int r = 0; r < 16; ++r) S[kk][r] = 0.f;
        if (live) {
            const LAS bf16_t* kp = sK + (32 * kb + r32) * KP + 8 * hh;
#pragma unroll
            for (int s = 0; s < 4; ++s) { const bf16x8 kf = *(const LAS bf16x8*)(kp + 16 * s); S[kk] = MFMA32(kf, qf[s], S[kk]); }
        }
#pragma unroll
        for (int r = 0; r < 16; ++r) { const int jb = 32 * kb + crow(r, hh); const int dist = iq - jb; const bool ok = live && dist >= 0 && dist <= 128; S[kk][r] = ok ? S[kk][r] : -1e30f; }
    }
    float mx = -1e30f;
#pragma unroll
    for (int kk = 0; kk < 5; ++kk)
#pragma unroll
        for (int r = 0; r < 16; ++r) mx = fmaxf(mx, S[kk][r]);
    mx = fmaxf(mx, __shfl_xor(mx, 32));
    float l = 0.f;
#pragma unroll
    for (int kk = 0; kk < 5; ++kk)
#pragma unroll
        for (int r = 0; r < 16; ++r) { const float e = __expf(S[kk][r] - mx); S[kk][r] = e; l += e; }
    l += __shfl_xor(l, 32);
    f32x16 O0, O1;
#pragma unroll
    for (int r = 0; r < 16; ++r) { O0[r] = 0.f; O1[r] = 0.f; }
#pragma unroll
    for (int kk = 0; kk < 5; ++kk) {
        const int kb = w3 + kk;
#pragma unroll
        for (int s = 0; s < 2; ++s) {
            const bf16x8 pf = pack8(S[kk], s);
            const int k0 = 32 * kb + 16 * s + 4 * hh, sw0 = (r32 >> 3) << 2, sw1 = sw0 + 16;
            const LAS bf16_t* v0 = sVT + r32 * VP;
            const LAS bf16_t* v1 = v0 + 32 * VP;
            O0 = MFMA32(ld2x8(v0 + (k0 ^ sw0), v0 + ((k0 + 8) ^ sw0)), pf, O0);
            O1 = MFMA32(ld2x8(v1 + (k0 ^ sw1), v1 + ((k0 + 8) ^ sw1)), pf, O1);
        }
    }
    const float il = 1.0f / l;
    bf16_t* po = PO + qrow * 512 + hq * 64;
#pragma unroll
    for (int q4 = 0; q4 < 4; ++q4) {
        const int d0 = 8 * q4 + 4 * hh;
        u32x2 o; o.x = pk2(O0[4 * q4] * il, O0[4 * q4 + 1] * il); o.y = pk2(O0[4 * q4 + 2] * il, O0[4 * q4 + 3] * il);
        *(u32x2*)(po + d0) = o;
        o.x = pk2(O1[4 * q4] * il, O1[4 * q4 + 1] * il); o.y = pk2(O1[4 * q4 + 2] * il, O1[4 * q4 + 3] * il);
        *(u32x2*)(po + 32 + d0) = o;
    }
    if (hh == 0) LSE[qrow * 8 + hq] = mx + __logf(l);
}

__device__ __forceinline__ void attn_sample_item(const Params& p, LAS unsigned char* lds, int item) {
    const int tid = threadIdx.x, lane = tid & 63, t = __builtin_amdgcn_readfirstlane(tid >> 6);
    const int g = item % 3, r = item / 3, kvh = r & 3, b = r >> 2;
    const int d = 1 << (2 * g);
    const int sub = lane >> 4, dl = lane & 15;
    const bf16_t* U = (const bf16_t*)(p.ws + WS_U);
    const size_t row = (size_t)MP + b * 8 + t;
    float q0[4], q1[4];
    { const u32x2 a = *(const u32x2*)(U + row * NU + (kvh * 2) * 64 + 4 * dl), c = *(const u32x2*)(U + row * NU + (kvh * 2 + 1) * 64 + 4 * dl);
      q0[0] = bflo(a.x); q0[1] = bfhi(a.x); q0[2] = bflo(a.y); q0[3] = bfhi(a.y); q1[0] = bflo(c.x); q1[1] = bfhi(c.x); q1[2] = bflo(c.y); q1[3] = bfhi(c.y); }
    const float* ck = p.cache_k + (size_t)b * WC * 256 + kvh * 64 + 4 * dl;
    const float* cv = p.cache_v + (size_t)b * WC * 256 + kvh * 64 + 4 * dl;
    const float* nk = p.out + O_KS + (size_t)b * WC * 256 + kvh * 64 + 4 * dl;
    const float* nv = p.out + O_VS + (size_t)b * WC * 256 + kvh * 64 + 4 * dl;
    float m0 = -1e30f, m1 = -1e30f, l0 = 0.f, l1 = 0.f; f32x4 o0 = (f32x4){0.f, 0.f, 0.f, 0.f}, o1 = o0;
#pragma unroll 1
    for (int bt = 0; bt < 3; ++bt) {
        f32x4 kv[11], vv[11];
#pragma unroll
        for (int u = 0; u < 11; ++u) { const int j = 4 * (bt * 11 + u) + sub, jc = j < 128 ? j : 128; const int idx = WC + t - d * jc;
            const size_t off = (idx < WC) ? (size_t)idx * 256 : (size_t)(idx - 8) * 256;
            kv[u] = *(const f32x4*)(((idx < WC) ? ck : nk) + off); vv[u] = *(const f32x4*)(((idx < WC) ? cv : nv) + off); }
        float a0[11], a1[11]; float bm0 = -1e30f, bm1 = -1e30f;
#pragma unroll
        for (int u = 0; u < 11; ++u) {
            const int j = 4 * (bt * 11 + u) + sub;
            float x0 = q0[0] * kv[u].x + q0[1] * kv[u].y + q0[2] * kv[u].z + q0[3] * kv[u].w;
            float x1 = q1[0] * kv[u].x + q1[1] * kv[u].y + q1[2] * kv[u].z + q1[3] * kv[u].w;
#pragma unroll
            for (int o = 1; o < 16; o <<= 1) { x0 += __shfl_xor(x0, o); x1 += __shfl_xor(x1, o); }
            if (j > 128) { x0 = -1e30f; x1 = -1e30f; }
            a0[u] = x0; a1[u] = x1; bm0 = fmaxf(bm0, x0); bm1 = fmaxf(bm1, x1);
        }
        bm0 = fmaxf(bm0, __shfl_xor(bm0, 16)); bm0 = fmaxf(bm0, __shfl_xor(bm0, 32)); bm1 = fmaxf(bm1, __shfl_xor(bm1, 16)); bm1 = fmaxf(bm1, __shfl_xor(bm1, 32));
        const float mn0 = fmaxf(m0, bm0), mn1 = fmaxf(m1, bm1); const float sc0 = __expf(m0 - mn0), sc1 = __expf(m1 - mn1);
        l0 *= sc0; l1 *= sc1; o0 = o0 * sc0; o1 = o1 * sc1; m0 = mn0; m1 = mn1;
#pragma unroll
        for (int u = 0; u < 11; ++u) {
            const int j = 4 * (bt * 11 + u) + sub;
            const float e0 = (j <= 128) ? __expf(a0[u] - m0) : 0.f, e1 = (j <= 128) ? __expf(a1[u] - m1) : 0.f;
            l0 += e0; l1 += e1; o0 += vv[u] * e0; o1 += vv[u] * e1;
        }
    }
#pragma unroll
    for (int o = 16; o < 64; o <<= 1) { l0 += __shfl_xor(l0, o); l1 += __shfl_xor(l1, o);
        o0.x += __shfl_xor(o0.x, o); o0.y += __shfl_xor(o0.y, o); o0.z += __shfl_xor(o0.z, o); o0.w += __shfl_xor(o0.w, o);
        o1.x += __shfl_xor(o1.x, o); o1.y += __shfl_xor(o1.y, o); o1.z += __shfl_xor(o1.z, o); o1.w += __shfl_xor(o1.w, o); }
    if (sub == 0) {
        bf16_t* PO = (bf16_t*)(p.ws + WS_PO) + (size_t)g * M * 512; float* LSE = (float*)(p.ws + WS_LSE) + (size_t)g * M * 8;
        const float i0 = 1.0f / l0, i1 = 1.0f / l1;
        u32x2 o; o.x = pk2(o0.x * i0, o0.y * i0); o.y = pk2(o0.z * i0, o0.w * i0); *(u32x2*)(PO + row * 512 + (kvh * 2) * 64 + 4 * dl) = o;
        o.x = pk2(o1.x * i1, o1.y * i1); o.y = pk2(o1.z * i1, o1.w * i1); *(u32x2*)(PO + row * 512 + (kvh * 2 + 1) * 64 + 4 * dl) = o;
        if (dl == 0) { LSE[row * 8 + kvh * 2] = m0 + __logf(l0); LSE[row * 8 + kvh * 2 + 1] = m1 + __logf(l1); }
    }
}

__device__ __forceinline__ void ssd_sample_item(const Params& p, LAS unsigned char* lds, int item) {
    const int tid = threadIdx.x, b = item >> 3, h = item & 7, g = h >> 2;
    const bf16_t* U = (const bf16_t*)(p.ws + WS_U); const float* DT = (const float*)(p.ws + WS_DT); bf16_t* Y = (bf16_t*)(p.ws + WS_Y);
    LAS float* sx = (LAS float*)lds;
    LAS float* sBn = sx + 512;
    LAS float* sCn = sBn + 1024;
    __syncthreads();
    for (int i = tid; i < 8 * 320; i += 512) {
        const int t = i / 320, c = i % 320;
        int ucol; if (c < 64) ucol = 1536 + h * 64 + c; else if (c < 192) ucol = 2048 + g * 128 + (c - 64); else ucol = 2304 + g * 128 + (c - 192);
        const int ch = ucol - 1536;
        float o = p.conv_b[ch];
#pragma unroll
        for (int tp = 0; tp < 4; ++tp) { const int r = t + tp;
            const float v = (r < 3) ? p.state_conv[((size_t)b * 3 + r) * 1024 + ch] : bf2f(U[((size_t)MP + b * 8 + (r - 3)) * NU + ucol]);
            o += p.conv_w[tp * 1024 + ch] * v; }
        o = silu(o);
        if (c < 64) sx[t * 64 + c] = o; else if (c < 192) sBn[t * 128 + c - 64] = o; else sCn[t * 128 + c - 192] = o;
    }
    __syncthreads();
    const int pp = tid >> 3, n0 = (tid & 7) * 16;
    const float Ah = -__expf(p.a_log[h]), dtb = p.dt_bias[h], Dsk = p.d_skip[h];
    const float* s0 = p.state_ssm + ((size_t)(b * 8 + h) * 64 + pp) * 128 + n0;
    float st[16];
#pragma unroll
    for (int k = 0; k < 4; ++k) { const f32x4 v = *(const f32x4*)(s0 + 4 * k); st[4 * k] = v.x; st[4 * k + 1] = v.y; st[4 * k + 2] = v.z; st[4 * k + 3] = v.w; }
    float dts[8], zs[8];
#pragma unroll
    for (int t = 0; t < 8; ++t) { const size_t row = (size_t)MP + b * 8 + t; dts[t] = DT[row * 8 + h]; zs[t] = bf2f(U[row * NU + 1024 + h * 64 + pp]); }
#pragma unroll
    for (int t = 0; t < 8; ++t) {
        const size_t row = (size_t)MP + b * 8 + t;
        const float dtv = softplus(dts[t] + dtb), dA = __expf(dtv * Ah);
        const float xv = sx[t * 64 + pp], xdt = xv * dtv;
        float y = 0.f;
#pragma unroll
        for (int k = 0; k < 16; ++k) { st[k] = st[k] * dA + xdt * sBn[t * 128 + n0 + k]; y += sCn[t * 128 + n0 + k] * st[k]; }
        y += __shfl_xor(y, 1); y += __shfl_xor(y, 2); y += __shfl_xor(y, 4);
        if ((tid & 7) == 0) {
            const float zv = zs[t];
            Y[row * 512 + h * 64 + pp] = (bf16_t)f2bf((y + Dsk * xv) * silu(zv));
        }
    }
    float* so = p.out + O_SS + ((size_t)(b * 8 + h) * 64 + pp) * 128 + n0;
#pragma unroll
    for (int k = 0; k < 4; ++k) *(f32x4*)(so + 4 * k) = (f32x4){st[4 * k], st[4 * k + 1], st[4 * k + 2], st[4 * k + 3]};
}


__device__ __forceinline__ void copy_item(const Params& p, int item) {
    const int tid = threadIdx.x, pr = item >> 2, part = item & 3, tns = pr >> 7, b = pr & 127;
    const f32x4* src = (const f32x4*)((tns ? p.cache_v : p.cache_k) + (size_t)b * WC * 256 + 8 * 256) + part * 32640 + tid;
    f32x4* dst = (f32x4*)(p.out + (tns ? O_VS : O_KS) + (size_t)b * WC * 256) + part * 32640 + tid;
    constexpr int NI = 32640;
    f32x4 va[8], vb[8];
#pragma unroll
    for (int u = 0; u < 8; ++u) { const int i = 512 * u; if (i + tid < NI) va[u] = __builtin_nontemporal_load(src + i); }
#pragma unroll 1
    for (int r = 0; r < 8; r += 2) {
#pragma unroll
        for (int u = 0; u < 8; ++u) { const int i = (r + 1) * 4096 + 512 * u; if (i + tid < NI) vb[u] = __builtin_nontemporal_load(src + i); }
#pragma unroll
        for (int u = 0; u < 8; ++u) { const int i = r * 4096 + 512 * u; if (i + tid < NI) __builtin_nontemporal_store(va[u], dst + i); }
#pragma unroll
        for (int u = 0; u < 8; ++u) { const int i = (r + 2) * 4096 + 512 * u; if (r + 2 < 8 && i + tid < NI) va[u] = __builtin_nontemporal_load(src + i); }
#pragma unroll
        for (int u = 0; u < 8; ++u) { const int i = (r + 1) * 4096 + 512 * u; if (i + tid < NI) __builtin_nontemporal_store(vb[u], dst + i); }
    }
}
constexpr int N_COPY = 1024;
#ifndef HY_CQ1
#define HY_CQ1 0
#define HY_CQ3 0
#define HY_CQ4 0
#define HY_CQ5 0
#endif
constexpr int N_COPY_P2 = N_COPY;
__device__ __forceinline__ void copy_quota(const Params& p, LAS unsigned char* lds, int quota) {
    unsigned* cctr = (unsigned*)(p.ws + WS_CTL) + 32;
    volatile LAS int* sItem = (volatile LAS int*)(lds + MISC_OFF);
    for (int q = 0; q < quota; ++q) {
        __syncthreads();
        if (threadIdx.x == 0) sItem[0] = (int)atomicAdd(cctr, 1u);
        __syncthreads();
        const int it = sItem[0];
        if (it >= N_COPY) break;
        copy_item(p, it);
    }
}
__device__ __forceinline__ bool short_block(int nwg) { const int G = gridDim.x, c = blockIdx.x; return (nwg - c + G - 1) / G < (nwg + G - 1) / G; }
constexpr int N_SSDP = 128, N_ATTP = 3072, N_SSDS = 1024, N_ATTS = 1536, N_P2 = N_SSDP + N_ATTP + N_SSDS + N_ATTS + N_COPY_P2;
__device__ __forceinline__ void phase2(const Params& p, LAS unsigned char* lds, int cidx, int ilo = 0, int ihi = 1 << 30) {
    unsigned* ctr = (unsigned*)(p.ws + WS_CTL) + cidx;
    volatile LAS int* sItem = (volatile LAS int*)(lds + MISC_OFF);
    for (;;) {
        __syncthreads();
        if (threadIdx.x == 0) sItem[0] = (int)atomicAdd(ctr, 1u);
        __syncthreads();
        int it = sItem[0] + ilo;
        if (it >= N_P2 || it >= ihi) break;
        if (it < N_SSDP) { if (HY_P2MASK & 1) ssd_prompt_unit(p, lds, it >> 3, it & 7); continue; } it -= N_SSDP;
        { const int grp = it / 13, pos = it % 13;
          if (pos == 5 || pos == 12) { copy_item(p, 2 * grp + (pos == 12)); continue; }
          it = grp * 11 + (pos < 5 ? pos : pos - 1); }
        if (it < N_ATTP) { if (HY_P2MASK & 2) attn_prompt_unit(p, lds, it); continue; } it -= N_ATTP;
        if (it < N_SSDS) { if (HY_P2MASK & 4) ssd_sample_item(p, lds, it); continue; } it -= N_SSDS;
        if (HY_P2MASK & 8) attn_sample_item(p, lds, it);
    }
}

__device__ __forceinline__ void phase2b(const Params& p) {
    const int tid = threadIdx.x, lane = tid & 63, wave = tid >> 6, gw = blockIdx.x * 8 + wave, NGW = gridDim.x * 8;
    const bf16_t* PO = (const bf16_t*)(p.ws + WS_PO); const float* LSE = (const float*)(p.ws + WS_LSE); const bf16_t* Y = (const bf16_t*)(p.ws + WS_Y);
    bf16_t* MIX = (bf16_t*)(p.ws + WS_MIX);
    const f32x4 sn0 = *(const f32x4*)(p.ssm_norm + 8 * lane), sn1 = *(const f32x4*)(p.ssm_norm + 8 * lane + 4);
    const int hd = lane >> 3;
    for (int row0 = gw; row0 < M; row0 += 4 * NGW) {
        u32x4 a[4], c[4], e[4], yq[4]; float l0[4], l1[4], l2[4];
#pragma unroll
        for (int r = 0; r < 4; ++r) { const int row = row0 + r * NGW; if (row < M) {
            l0[r] = LSE[(size_t)row * 8 + hd]; l1[r] = LSE[((size_t)M + row) * 8 + hd]; l2[r] = LSE[((size_t)2 * M + row) * 8 + hd];
            a[r] = *(const u32x4*)(PO + (size_t)row * 512 + 8 * lane); c[r] = *(const u32x4*)(PO + ((size_t)M + row) * 512 + 8 * lane); e[r] = *(const u32x4*)(PO + ((size_t)2 * M + row) * 512 + 8 * lane);
            yq[r] = *(const u32x4*)(Y + (size_t)row * 512 + 8 * lane); } }
#pragma unroll
        for (int r = 0; r < 4; ++r) { const int row = row0 + r * NGW; if (row < M) {
            const float mx = fmaxf(l0[r], fmaxf(l1[r], l2[r])); float w0 = __expf(l0[r] - mx), w1 = __expf(l1[r] - mx), w2 = __expf(l2[r] - mx);
            const float iw = 1.0f / (w0 + w1 + w2); w0 *= iw; w1 *= iw; w2 *= iw;
            u32x4 o;
            o.x = pk2(w0 * bflo(a[r].x) + w1 * bflo(c[r].x) + w2 * bflo(e[r].x), w0 * bfhi(a[r].x) + w1 * bfhi(c[r].x) + w2 * bfhi(e[r].x));
            o.y = pk2(w0 * bflo(a[r].y) + w1 * bflo(c[r].y) + w2 * bflo(e[r].y), w0 * bfhi(a[r].y) + w1 * bfhi(c[r].y) + w2 * bfhi(e[r].y));
            o.z = pk2(w0 * bflo(a[r].z) + w1 * bflo(c[r].z) + w2 * bflo(e[r].z), w0 * bfhi(a[r].z) + w1 * bfhi(c[r].z) + w2 * bfhi(e[r].z));
            o.w = pk2(w0 * bflo(a[r].w) + w1 * bflo(c[r].w) + w2 * bflo(e[r].w), w0 * bfhi(a[r].w) + w1 * bfhi(c[r].w) + w2 * bfhi(e[r].w));
            *(u32x4*)(MIX + (size_t)row * 1024 + 8 * lane) = o;
            const u32x4 q = yq[r];
            float y[8] = {bflo(q.x), bfhi(q.x), bflo(q.y), bfhi(q.y), bflo(q.z), bfhi(q.z), bflo(q.w), bfhi(q.w)};
            float ss = 0.f;
#pragma unroll
            for (int k = 0; k < 8; ++k) ss += y[k] * y[k];
#pragma unroll
            for (int of = 1; of < 32; of <<= 1) ss += __shfl_xor(ss, of);
            const float rstd = 1.0f / sqrtf(ss * (1.0f / 256.0f) + EPS);
            u32x4 oy; oy.x = pk2(y[0] * rstd * sn0.x, y[1] * rstd * sn0.y); oy.y = pk2(y[2] * rstd * sn0.z, y[3] * rstd * sn0.w);
            oy.z = pk2(y[4] * rstd * sn1.x, y[5] * rstd * sn1.y); oy.w = pk2(y[6] * rstd * sn1.z, y[7] * rstd * sn1.w);
            *(u32x4*)(MIX + (size_t)row * 1024 + 512 + 8 * lane) = oy; } }
    }
}

__device__ __forceinline__ void phase6(const Params& p) {
    const int tid = threadIdx.x, lane = tid & 63, wave = tid >> 6, gw = blockIdx.x * 8 + wave, NGW = gridDim.x * 8;
    f32x4 g[4];
#pragma unroll
    for (int j = 0; j < 4; ++j) g[j] = ((const f32x4*)p.norm_final)[lane + 64 * j];
    for (int row0 = gw; row0 < M; row0 += 4 * NGW) {
        f32x4 v[4][4];
#pragma unroll
        for (int r = 0; r < 4; ++r) { const int row = row0 + r * NGW; if (row < M) {
            if (row < MP) {
                const u32x2* h2 = (const u32x2*)((const bf16_t*)(p.ws + WS_MIX) + (size_t)row * D);
#pragma unroll
                for (int j = 0; j < 4; ++j) { const u32x2 q = h2[lane + 64 * j]; v[r][j] = (f32x4){bflo(q.x), bfhi(q.x), bflo(q.y), bfhi(q.y)}; }
            } else {
                const f32x4* hr = (const f32x4*)(p.out + (size_t)row * D);
                const f32x4* pr = (const f32x4*)((const float*)(p.ws + WS_PO) + (size_t)(row - MP) * D);
#pragma unroll
                for (int j = 0; j < 4; ++j) { v[r][j] = hr[lane + 64 * j];
#pragma unroll
                    for (int k = 0; k < 4; ++k) v[r][j] += pr[(size_t)k * MS * D / 4 + lane + 64 * j]; }
            } } }
#pragma unroll
        for (int r = 0; r < 4; ++r) { const int row = row0 + r * NGW; if (row < M) {
            float s = 0.f;
#pragma unroll
            for (int j = 0; j < 4; ++j) s += (v[r][j].x * v[r][j].x + v[r][j].y * v[r][j].y) + (v[r][j].z * v[r][j].z + v[r][j].w * v[r][j].w);
            s = wave_sum(s);
            const float rstd = 1.0f / sqrtf(s * (1.0f / 1024.0f) + EPS);
            f32x4* hr = (f32x4*)(p.out + (size_t)row * D);
#pragma unroll
            for (int j = 0; j < 4; ++j) hr[lane + 64 * j] = v[r][j] * rstd * g[j]; } }
    }
}

#define XB_TMO      128
#define XB_XCNT(j)  (256  + 64 * (j))
#define XB_XSUB(j)  (1280 + 64 * (j))
#define XB_XGEN(j)  (2304 + 64 * (j))
#define XB_TOP      3328
#define XB_TOPGEN   3392
#define XCD_BAR_WORDS 3456
#define XB_SPIN_CAP (1u << 18)

__device__ __forceinline__ unsigned xb_ld(unsigned* p)              { return __hip_atomic_load(p, __ATOMIC_RELAXED, __HIP_MEMORY_SCOPE_AGENT); }
__device__ __forceinline__ unsigned xb_add(unsigned* p, unsigned v) { return __hip_atomic_fetch_add(p, v, __ATOMIC_RELAXED, __HIP_MEMORY_SCOPE_AGENT); }
__device__ __forceinline__ unsigned xb_xcc_id() { return (unsigned)__builtin_amdgcn_s_getreg((3 << 11) | 20) & 0xFu; }
#define XB_SPIN(cond, bar) do { unsigned _sp = 0; while (cond) { __builtin_amdgcn_s_sleep(1); \
    if ((++_sp & 255u) == 0u) { if (xb_ld(&(bar)[XB_TMO])) break; if (_sp > XB_SPIN_CAP) { atomicAdd(&(bar)[XB_TMO], 1u); break; } } } } while (0)

struct XcdBarrier {
    unsigned* bar; unsigned x;
    volatile LAS unsigned* st;
};

__device__ __forceinline__ XcdBarrier xcd_barrier_post(unsigned* bar, volatile LAS unsigned* st) {
    XcdBarrier b; b.bar = bar; b.x = xb_xcc_id(); b.st = st;
    if (threadIdx.x == 0) (void)xb_add(&bar[XB_XCNT(b.x)], 1u);
    return b;
}
__device__ __forceinline__ void xcd_barrier_complete(unsigned* bar, unsigned x, unsigned& nloc, unsigned& nx) {
    const unsigned G = gridDim.x * gridDim.y * gridDim.z;
    unsigned sum, cnt, mine, sp = 0u;
    for (;;) {
        sum = 0u; cnt = 0u; mine = 0u;
#pragma unroll
        for (unsigned j = 0; j < 16; ++j) { const unsigned c = xb_ld(&bar[XB_XCNT(j)]); sum += c; cnt += (c > 0u) ? 1u : 0u; mine = (j == x) ? c : mine; }
        if (sum == G) break;
        __builtin_amdgcn_s_sleep(1);
        if ((++sp & 255u) == 0u) { if (xb_ld(&bar[XB_TMO])) break; if (sp > XB_SPIN_CAP) { atomicAdd(&bar[XB_TMO], 1u); break; } }
    }
    nloc = mine > 0u ? mine : 1u; nx = cnt > 0u ? cnt : 1u;
}

__device__ __forceinline__ void xcd_barrier(const XcdBarrier& b) {
    asm volatile("s_waitcnt vmcnt(0)" ::: "memory");
    __syncthreads();
    if (threadIdx.x == 0) {
        unsigned* bar = b.bar;
        __builtin_amdgcn_s_waitcnt(0);
        unsigned nloc = b.st[0], nx = b.st[1];
        if (nloc == 0u) { xcd_barrier_complete(bar, b.x, nloc, nx); b.st[0] = nloc; b.st[1] = nx; }
        const unsigned old = xb_add(&bar[XB_XSUB(b.x)], 1u);
        const unsigned gen = old / nloc;
        if (old + 1u == (gen + 1u) * nloc) {
            __builtin_amdgcn_fence(__ATOMIC_RELEASE, "agent");
            asm volatile("s_waitcnt vmcnt(0)" ::: "memory");
            const unsigned og = xb_add(&bar[XB_TOP], 1u);
            const unsigned tg = og / nx;
            if (og + 1u == (tg + 1u) * nx) xb_add(&bar[XB_TOPGEN], 1u);
            else XB_SPIN(xb_ld(&bar[XB_TOPGEN]) == tg, bar);
            __builtin_amdgcn_fence(__ATOMIC_ACQUIRE, "agent");
            xb_add(&bar[XB_XGEN(b.x)], 1u);
            asm volatile("s_waitcnt vmcnt(0)" ::: "memory");
        } else {
            XB_SPIN(xb_ld(&bar[XB_XGEN(b.x)]) == gen, bar);
            __builtin_amdgcn_fence(__ATOMIC_ACQUIRE, "agent");
            asm volatile("s_waitcnt vmcnt(0)" ::: "memory");
        }
    }
    __syncthreads();
}


__global__ void __launch_bounds__(512, 2) hymba_fwd(Params p) {
    extern __shared__ __attribute__((aligned(16))) unsigned char lds_raw[];
    LAS unsigned char* lds = (LAS unsigned char*)lds_raw;
    cg::grid_group grid = cg::this_grid();
    unsigned char* ws = p.ws;
    float* ssq1 = (float*)(ws + WS_CTL + 4096); float* ssq2 = ssq1 + M;
    const int lo = p.ph_lo, hi = p.ph_hi;
    volatile LAS unsigned* xst = (volatile LAS unsigned*)(lds + MISC_OFF + 64);
    if (threadIdx.x < 2) xst[threadIdx.x] = 0u;
    __syncthreads();
    XcdBarrier xbar = xcd_barrier_post((unsigned*)(ws + WS_CTL + 524288), xst);
#define IN(k) (((HY_MASK >> (k)) & 1) && lo <= (k) && (k) < hi)
#define SEAM(k) do { if (IN(k) && IN((k) + 1)) { if (lo < 0) grid.sync(); else xcd_barrier(xbar); } } while (0)
    if (IN(0)) { phase0(p, lds); if (HY_DUP == 0) { grid.sync(); phase0(p, lds); } } SEAM(0);
    if (IN(1)) {
        pg8::Gemm gm{(const bf16_t*)(ws + WS_XN), (const bf16_t*)(ws + WS_WIN), M, NU, D, D}; pg8::StaticOrder S; S.init(M, NU, (int)gridDim.x, (int)blockIdx.x);
        EpiIn E{(bf16_t*)(ws + WS_U), p.out, (const float*)(ws + WS_ROPE)};
        pg8::gemm_phase<EpiIn, pg8::StaticOrder, true, true>(lds, gm, S, E);
        if (HY_DUP == 1) { grid.sync(); pg8::gemm_phase<EpiIn, pg8::StaticOrder, true, true>(lds, gm, S, E); }
        if (HY_DUP == 1) { grid.sync(); pg8::gemm_phase<EpiIn, pg8::StaticOrder, true, true>(lds, gm, S, E); }
        if (short_block((M / 256) * (NU / 256))) copy_quota(p, lds, HY_CQ1);
    } SEAM(1);
    if (IN(2)) { phase2(p, lds, 0); if (HY_DUP == 2) { grid.sync(); phase2(p, lds, 16, HY_DLO, HY_DHI); } } SEAM(2);
    if (IN(3)) { phase2b(p); if (HY_DUP == 3) { grid.sync(); phase2b(p); } } SEAM(3);
    if (IN(4)) {
        pg8::Gemm gm{(const bf16_t*)(ws + WS_MIX), (const bf16_t*)(ws + WS_WOUT), M, D, D, D}; pg8::StaticOrder S; S.init(M, D, (int)gridDim.x, (int)blockIdx.x);
        EpiOut E{p.x_prompt, p.x_sample, p.out, (bf16_t*)(ws + WS_XN), p.norm_mlp, ssq1, (bf16_t*)(ws + WS_U)};
        pg8::gemm_phase<EpiOut, pg8::StaticOrder, true, true>(lds, gm, S, E);
        if (short_block((M / 256) * (D / 256))) copy_quota(p, lds, HY_CQ3);
    } SEAM(4);
    if (IN(5)) {
        pg8::Gemm gm{(const bf16_t*)(ws + WS_XN), (const bf16_t*)(ws + WS_WUP), M, FF, D, D}; pg8::StaticOrder S; S.init(M, FF, (int)gridDim.x, (int)blockIdx.x);
        EpiUp E{ssq1, (bf16_t*)(ws + WS_H)};
        pg8::gemm_phase<EpiUp, pg8::StaticOrder, true, true>(lds, gm, S, E);
        if (HY_DUP == 5) { grid.sync(); pg8::gemm_phase<EpiUp, pg8::StaticOrder, true, true>(lds, gm, S, E); }
        if (short_block((M / 256) * (FF / 256))) copy_quota(p, lds, HY_CQ4);
    } SEAM(5);
    if (IN(6)) {
        { pg8::Gemm gm{(const bf16_t*)(ws + WS_H), (const bf16_t*)(ws + WS_WDN), MP, D, FF, FF}; pg8::StaticOrder S; S.init(MP, D, (int)gridDim.x, (int)blockIdx.x);
          EpiDown E{(const bf16_t*)(ws + WS_U), (bf16_t*)(ws + WS_MIX)};
          pg8::gemm_phase<EpiDown, pg8::StaticOrder, true, true>(lds, gm, S, E); }
        { pg8::Gemm gm{(const bf16_t*)(ws + WS_H) + (size_t)MP * FF, (const bf16_t*)(ws + WS_WDN), MS, D, 1024, FF}; SplitOrder S{(int)gridDim.x, (int)blockIdx.x};
          EpiDownAtomic E{(float*)(ws + WS_PO)};
          pg8::gemm_phase<EpiDownAtomic, SplitOrder, true, true>(lds, gm, S, E); }
    } SEAM(6);
    if (IN(7)) { phase6(p); }
    if (HY_DUP == 9) { for (int k = 0; k < 8; ++k) grid.sync(); }
#undef IN
#undef SEAM
}
}

extern "C" void kernel_launch(void* const* d_in, const int* in_sizes, int n_in, void* d_out, int out_size, void* d_ws, size_t ws_size, hipStream_t stream) {
    using namespace hy;
    static int grid = 0;
    if (grid == 0) {
        if (n_in != 19 || (size_t)out_size != O_END || ws_size < WS_END) { fprintf(stderr, "kernel_launch: unexpected shapes (n_in %d out %d ws %zu)\n", n_in, out_size, ws_size); grid = -1; return; }
        int dev = 0, cus = 0, per_cu = 0;
        (void)hipGetDevice(&dev); (void)hipDeviceGetAttribute(&cus, hipDeviceAttributeMultiprocessorCount, dev);
        if (hipFuncSetAttribute((const void*)hymba_fwd, hipFuncAttributeMaxDynamicSharedMemorySize, LDS_BYTES) != hipSuccess) { fprintf(stderr, "kernel_launch: hipFuncSetAttribute failed\n"); grid = -1; return; }
        if (hipOccupancyMaxActiveBlocksPerMultiprocessor(&per_cu, (const void*)hymba_fwd, 512, LDS_BYTES) != hipSuccess || per_cu < 1) { fprintf(stderr, "kernel_launch: occupancy query says %d\n", per_cu); per_cu = 1; }
        (void)hipGetLastError();
        grid = cus > 0 ? cus : 256;
    }
    if (grid < 0) return;
    (void)hipMemsetAsync((char*)d_ws + WS_CTL, 0, CTL_BYTES, stream);
    Params p{};
    p.x_prompt = (const float*)d_in[0]; p.x_sample = (const float*)d_in[1]; p.cache_k = (const float*)d_in[2]; p.cache_v = (const float*)d_in[3];
    p.state_conv = (const float*)d_in[4]; p.state_ssm = (const float*)d_in[5]; p.w_in = (const float*)d_in[6]; p.w_out = (const float*)d_in[7];
    p.conv_w = (const float*)d_in[8]; p.conv_b = (const float*)d_in[9]; p.dt_bias = (const float*)d_in[10]; p.a_log = (const float*)d_in[11];
    p.d_skip = (const float*)d_in[12]; p.ssm_norm = (const float*)d_in[13]; p.norm_mix = (const float*)d_in[14]; p.norm_mlp = (const float*)d_in[15];
    p.w_up = (const float*)d_in[16]; p.w_down = (const float*)d_in[17]; p.norm_final = (const float*)d_in[18];
    p.out = (float*)d_out; p.ws = (unsigned char*)d_ws;
#if HY_N_LAUNCHES == 1
    p.ph_lo = 0; p.ph_hi = 8;
    { void* args[] = {&p}; hipError_t e = hipLaunchCooperativeKernel((const void*)hymba_fwd, dim3(grid), dim3(512), args, LDS_BYTES, stream);
      if (e != hipSuccess) fprintf(stderr, "cooperative launch failed: %s (grid %d)\n", hipGetErrorString(e), grid); }
#else
    for (int ph = 0; ph < 8; ++ph) { p.ph_lo = ph; p.ph_hi = ph + 1; void* args[] = {&p};
        hipError_t e = hipLaunchCooperativeKernel((const void*)hymba_fwd, dim3(grid), dim3(512), args, LDS_BYTES, stream);
        if (e != hipSuccess) { fprintf(stderr, "cooperative launch %d failed: %s (grid %d)\n", ph, hipGetErrorString(e), grid); break; } }
#endif
}
```

```cpp
#include <hip/hip_runtime.h>
#include <hip/hip_cooperative_groups.h>
#include <cstdio>
#include <cstdint>
namespace cg = cooperative_groups;
namespace pg8 {
#define PG8_LAS __attribute__((address_space(3)))
typedef unsigned short bf16_t;
typedef short bf16x8 __attribute__((ext_vector_type(8)));
typedef float f32x4 __attribute__((ext_vector_type(4)));
typedef unsigned u32x4 __attribute__((ext_vector_type(4)));
constexpr int BM = 256, BK = 64, HALF = 128, HTB = HALF * BK * 2  , STAGE_BYTES = 8 * HTB, NXCD = 8, WGM = 8;

__host__ __device__ __forceinline__ int lds_byte(int r, int c) { const int st = (r >> 4) * 2 + (c >> 5), rr = r & 15, cc = c & 31, ob = rr * 64 + cc * 2; return st * 1024 + (ob ^ (((ob >> 9) & 1) << 5)); }
__host__ __device__ __forceinline__ void stage_rc(int b, int& R, int& C) { const int st = b / 1024, sb = b % 1024, swz = sb ^ (((sb >> 9) & 1) << 5); R = (st >> 1) * 16 + swz / 64; C = (st & 1) * 32 + (swz % 64) / 2; }
__host__ __device__ __forceinline__ int perm32(int rho) { const int n = rho >> 4, i = rho & 15; return 8 * (i >> 2) + 4 * n + (i & 3); }

struct Unit { int pm, pn, k0; };
struct Gemm { const bf16_t* A; const bf16_t* Bt; int M, N, K, ld; };

struct StaticOrder {
    int nM, nN, nwg, G, c;
    __host__ __device__ void init(int M, int N, int G_, int c_) { nM = M / BM; nN = N / BM; nwg = nM * nN; G = G_; c = c_; }
    __host__ __device__ bool next(int i, Unit& u) const {
        const long L = (long)i * G + c; if (L >= nwg) return false;
        int wgid = (int)L; { const int q = nwg / NXCD, r = nwg % NXCD, xcd = wgid % NXCD, off = wgid / NXCD; wgid = (xcd < r ? xcd * (q + 1) : r * (q + 1) + (xcd - r) * q) + off; }
        const int nig = WGM * nN, gid = wgid / nig, fm = gid * WGM, gsz = (nM - fm) < WGM ? (nM - fm) : WGM;
        u.pm = fm + ((wgid % nig) % gsz); u.pn = (wgid % nig) / gsz; u.k0 = 0; return true;
    }
    __device__ __forceinline__ void a_ready(const Unit&) const {}
    __device__ __forceinline__ void done(const Unit&) const {}
};
__device__ __forceinline__ unsigned cvt_pk_bf16(float lo, float hi) { unsigned r; asm volatile("v_cvt_pk_bf16_f32 %0, %1, %2" : "=v"(r) : "v"(lo), "v"(hi)); return r; }

template <class Epi, class Sched, bool ALIGN_EPI = false, bool SP2 = false>
__device__ __forceinline__ void gemm_phase(PG8_LAS unsigned char* lds, const Gemm g, const Sched& S, const Epi& E) {
    const int tid = threadIdx.x, wid = __builtin_amdgcn_readfirstlane(tid >> 6), lane = tid & 63, wr = wid >> 2, wc = wid & 3, fr = lane & 15, fq = lane >> 4;
    const int K = g.ld, nt = g.K / BK;
    unsigned voffA[2], voffB[2];
#pragma unroll
    for (int i = 0; i < 2; ++i) { int R, C; stage_rc(tid * 16 + i * 8192, R, C); const int Rb = Epi::PERM ? ((R & ~31) + perm32(R & 31)) : R;
        voffA[i] = (unsigned)(R * K + C) * 2u; voffB[i] = (unsigned)(Rb * K + C) * 2u; }
    const size_t kstep = (size_t)(BK * 2);
    const size_t hstep = (size_t)HALF * K * 2;
    const size_t tstep = 2 * hstep;
    const unsigned ldsw = (unsigned)wid * 1024u;
    const int aoff = lds_byte(wr * 64 + fr, fq * 8), boff = lds_byte(wc * 32 + fr, fq * 8);
#define PG8_SA(b, h) (((b) * 2 + (h)) * HTB)
#define PG8_SB(b, h) ((4 + (b) * 2 + (h)) * HTB)
#define PG8_STAGE(bufoff, gbase, voff) do { _Pragma("unroll") for (int _i = 0; _i < 2; ++_i) \
        __builtin_amdgcn_global_load_lds((const unsigned*)((const char*)(gbase) + (voff)[_i]), (PG8_LAS unsigned*)(lds + (bufoff) + ldsw + _i * 8192), 16, 0, 0); } while (0)
#define PG8_LDA(dst, b, h) do { _Pragma("unroll") for (int m = 0; m < 4; ++m) _Pragma("unroll") for (int k = 0; k < 2; ++k) dst[m][k] = *(const PG8_LAS bf16x8*)(lds + PG8_SA(b, h) + aoff + m * 2048 + k * 1024); } while (0)
#define PG8_LDB(dst, b, h) do { _Pragma("unroll") for (int n = 0; n < 2; ++n) _Pragma("unroll") for (int k = 0; k < 2; ++k) dst[n][k] = *(const PG8_LAS bf16x8*)(lds + PG8_SB(b, h) + boff + n * 2048 + k * 1024); } while (0)
#define PG8_MMA(ai, bj, At, Bt) do { __builtin_amdgcn_s_setprio(1); _Pragma("unroll") for (int m = 0; m < 4; ++m) _Pragma("unroll") for (int n = 0; n < 2; ++n) _Pragma("unroll") for (int k = 0; k < 2; ++k) \
        acc[ai][bj][m][n] = __builtin_amdgcn_mfma_f32_16x16x32_bf16(Bt[n][k], At[m][k], acc[ai][bj][m][n], 0, 0, 0); __builtin_amdgcn_s_setprio(0); } while (0)
#define PG8_WAIT_V(n) asm volatile("s_waitcnt vmcnt(" #n ")" ::: "memory")
#define PG8_WAIT_L(n) asm volatile("s_waitcnt lgkmcnt(" #n ")" ::: "memory")
#define PG8_BAR __builtin_amdgcn_s_barrier()
#define PG8_SCHED __builtin_amdgcn_sched_barrier(0)
    Unit cur, nxt; int ui = 0;
    if (!S.next(0, cur)) return;
    f32x4 acc[2][2][4][2];
#pragma unroll
    for (int a = 0; a < 2; ++a)
#pragma unroll
        for (int b = 0; b < 2; ++b)
#pragma unroll
            for (int m = 0; m < 4; ++m)
#pragma unroll
                for (int n = 0; n < 2; ++n) acc[a][b][m][n] = (f32x4){0.f, 0.f, 0.f, 0.f};
    bf16x8 At[4][2], B0[2][2], B1[2][2];
    const char* cA = (const char*)g.A + (size_t)cur.pm * tstep + (size_t)cur.k0 * 2; const char* cB = (const char*)g.Bt + (size_t)cur.pn * tstep + (size_t)cur.k0 * 2;
    S.a_ready(cur);
    if constexpr (SP2) {
        PG8_STAGE(PG8_SB(0, 0), cB, voffB); PG8_STAGE(PG8_SB(0, 1), cB + hstep, voffB); PG8_STAGE(PG8_SA(0, 0), cA, voffA); PG8_STAGE(PG8_SA(0, 1), cA + hstep, voffA);
        if (wr == 1) PG8_BAR;
        PG8_WAIT_V(2); PG8_BAR;
        PG8_STAGE(PG8_SB(1, 0), cB + kstep, voffB); PG8_STAGE(PG8_SA(1, 0), cA + kstep, voffA); PG8_STAGE(PG8_SB(1, 1), cB + hstep + kstep, voffB);
        PG8_WAIT_V(6); PG8_BAR;
    } else {
        PG8_STAGE(PG8_SB(0, 0), cB, voffB); PG8_STAGE(PG8_SA(0, 0), cA, voffA); PG8_STAGE(PG8_SB(0, 1), cB + hstep, voffB); PG8_STAGE(PG8_SA(0, 1), cA + hstep, voffA);
        if (wr == 1) PG8_BAR;
        PG8_WAIT_V(4); PG8_BAR;
        PG8_STAGE(PG8_SB(1, 0), cB + kstep, voffB); PG8_STAGE(PG8_SA(1, 0), cA + kstep, voffA); PG8_STAGE(PG8_SB(1, 1), cB + hstep + kstep, voffB);
        PG8_WAIT_V(6); PG8_BAR;
    }
    for (;;) {
        const bool has_next = S.next(ui + 1, nxt);
        const char* nA = has_next ? (const char*)g.A + (size_t)nxt.pm * tstep + (size_t)nxt.k0 * 2 : cA; const char* nB = has_next ? (const char*)g.Bt + (size_t)nxt.pn * tstep + (size_t)nxt.k0 * 2 : cB;
        for (int t = 0; t < nt; t += 2) {
            const bool last = (t == nt - 2);
            const char* a1 = cA + (size_t)(t + 1) * kstep;
            const char* a2 = last ? nA : cA + (size_t)(t + 2) * kstep; const char* b2 = last ? nB : cB + (size_t)(t + 2) * kstep;
            const char* a3 = a2 + kstep; const char* b3 = b2 + kstep;
            if (last && has_next) S.a_ready(nxt);
            if constexpr (SP2) {
            PG8_LDB(B0, 0, 0); PG8_LDB(B1, 0, 1); PG8_SCHED; PG8_LDA(At, 0, 0); PG8_STAGE(PG8_SA(1, 1), a1 + hstep, voffA);
            PG8_WAIT_V(8); PG8_WAIT_L(0); PG8_BAR; PG8_MMA(0, 0, At, B0); PG8_MMA(0, 1, At, B1); PG8_BAR; PG8_SCHED;
            PG8_LDA(At, 0, 1); PG8_STAGE(PG8_SB(0, 0), b2, voffB); PG8_STAGE(PG8_SB(0, 1), b2 + hstep, voffB); PG8_STAGE(PG8_SA(0, 0), a2, voffA);
            PG8_WAIT_V(8); PG8_WAIT_L(0); PG8_BAR; PG8_MMA(1, 0, At, B0); PG8_MMA(1, 1, At, B1); PG8_BAR; PG8_SCHED;
            PG8_LDB(B0, 1, 0); PG8_LDB(B1, 1, 1); PG8_SCHED; PG8_LDA(At, 1, 0); PG8_STAGE(PG8_SA(0, 1), a2 + hstep, voffA);
            PG8_WAIT_V(8); PG8_WAIT_L(0); PG8_BAR; PG8_MMA(0, 0, At, B0); PG8_MMA(0, 1, At, B1); PG8_BAR; PG8_SCHED;
            PG8_LDA(At, 1, 1); PG8_STAGE(PG8_SB(1, 0), b3, voffB); PG8_STAGE(PG8_SB(1, 1), b3 + hstep, voffB); PG8_STAGE(PG8_SA(1, 0), a3, voffA);
            PG8_WAIT_V(8); PG8_WAIT_L(0); PG8_BAR; PG8_MMA(1, 0, At, B0); PG8_MMA(1, 1, At, B1); PG8_BAR; PG8_SCHED;
            } else {
            PG8_LDB(B0, 0, 0); PG8_SCHED; PG8_LDA(At, 0, 0); PG8_STAGE(PG8_SA(1, 1), a1 + hstep, voffA);
            PG8_WAIT_L(8); PG8_BAR; PG8_WAIT_L(0); PG8_MMA(0, 0, At, B0); PG8_BAR; PG8_SCHED;
            PG8_LDB(B1, 0, 1); PG8_STAGE(PG8_SB(0, 0), b2, voffB);
            PG8_BAR; PG8_WAIT_L(0); PG8_MMA(0, 1, At, B1); PG8_BAR;
            PG8_LDA(At, 0, 1); PG8_STAGE(PG8_SA(0, 0), a2, voffA);
            PG8_BAR; PG8_WAIT_L(0); PG8_MMA(1, 0, At, B0); PG8_BAR; PG8_SCHED;
            PG8_STAGE(PG8_SB(0, 1), b2 + hstep, voffB);
            PG8_WAIT_V(6); PG8_BAR; PG8_MMA(1, 1, At, B1); PG8_BAR;
            PG8_LDB(B0, 1, 0); PG8_SCHED; PG8_LDA(At, 1, 0); PG8_STAGE(PG8_SA(0, 1), a2 + hstep, voffA);
            PG8_WAIT_L(8); PG8_BAR; PG8_WAIT_L(0); PG8_MMA(0, 0, At, B0); PG8_BAR; PG8_SCHED;
            PG8_LDB(B1, 1, 1); PG8_STAGE(PG8_SB(1, 0), b3, voffB);
            PG8_BAR; PG8_WAIT_L(0); PG8_MMA(0, 1, At, B1); PG8_BAR;
            PG8_LDA(At, 1, 1); PG8_STAGE(PG8_SA(1, 0), a3, voffA);
            PG8_BAR; PG8_WAIT_L(0); PG8_MMA(1, 0, At, B0); PG8_BAR; PG8_SCHED;
            PG8_STAGE(PG8_SB(1, 1), b3 + hstep, voffB);
            PG8_WAIT_V(6); PG8_BAR; PG8_MMA(1, 1, At, B1); PG8_BAR;
            }
        }
        if constexpr (ALIGN_EPI) { if (wr == 0) PG8_BAR; }
        if constexpr (!Epi::AFTER_DRAIN) { E(acc, cur, wr, wc, fr, fq); S.done(cur); }
        if (!has_next) break;
#pragma unroll
        for (int a = 0; a < 2; ++a)
#pragma unroll
            for (int b = 0; b < 2; ++b)
#pragma unroll
                for (int m = 0; m < 4; ++m)
#pragma unroll
                    for (int n = 0; n < 2; ++n) acc[a][b][m][n] = (f32x4){0.f, 0.f, 0.f, 0.f};
        cur = nxt; cA = nA; cB = nB; ++ui;
        if constexpr (ALIGN_EPI) { if (wr == 1) PG8_BAR; }
    }
    PG8_WAIT_V(0);
    if constexpr (!ALIGN_EPI) { if (wr == 0) PG8_BAR; }
    PG8_BAR;
    if constexpr (Epi::AFTER_DRAIN) { E.fused(acc, cur, wr, wc, fr, fq, lds, wid, lane); S.done(cur); }
#undef PG8_SA
#undef PG8_SB
#undef PG8_STAGE
#undef PG8_LDA
#undef PG8_LDB
#undef PG8_MMA
#undef PG8_WAIT_V
#undef PG8_WAIT_L
#undef PG8_BAR
#undef PG8_SCHED
}
}

#ifndef HY_MASK
#define HY_MASK 255
#endif
#ifndef HY_P2MASK
#define HY_P2MASK 15
#endif
#ifndef HY_T1
#define HY_T1 1
#endif
#ifndef HY_T2
#define HY_T2 1
#endif
#ifndef HY_T3
#define HY_T3 1
#endif
#ifndef HY_DUP
#define HY_DUP -1
#endif
#ifndef HY_DLO
#define HY_DLO 0
#define HY_DHI (1 << 30)
#endif
#ifndef HY_N_LAUNCHES
#define HY_N_LAUNCHES 1
#endif
namespace hy {
#define LAS __attribute__((address_space(3)))
using pg8::bf16_t; using pg8::bf16x8; using pg8::f32x4; using pg8::u32x4; using pg8::Unit;
typedef float f32x16 __attribute__((ext_vector_type(16)));
typedef unsigned u32x2 __attribute__((ext_vector_type(2)));

constexpr int MP = 32768, MS = 1024, M = MP + MS, D = 1024, NU = 2560, NIN = 2568, FF = 4096;
constexpr int SEQ = 2048, NBATCH = 16, DBATCH = 128, DSEQ = 8, WC = 2048;
constexpr float EPS = 1e-5f;
constexpr size_t O_YP = 0, O_YS = O_YP + (size_t)MP * D, O_KP = O_YS + (size_t)MS * D, O_VP = O_KP + (size_t)MP * 256,
                 O_CP = O_VP + (size_t)MP * 256, O_SP = O_CP + (size_t)NBATCH * 3 * 1024, O_KS = O_SP + (size_t)NBATCH * 8 * 64 * 128,
                 O_VS = O_KS + (size_t)DBATCH * WC * 256, O_CS = O_VS + (size_t)DBATCH * WC * 256, O_SS = O_CS + (size_t)DBATCH * 3 * 1024,
                 O_END = O_SS + (size_t)DBATCH * 8 * 64 * 128;
constexpr size_t MiB = 1u << 20;
constexpr size_t WS_CTL = 0, CTL_BYTES = 1 * MiB;
constexpr size_t WS_WIN = 1 * MiB, WS_WOUT = 6 * MiB, WS_WUP = 8 * MiB, WS_WDN = 16 * MiB, WS_ROPE = 24 * MiB, WS_DT = 25 * MiB, WS_LSE = 27 * MiB;
constexpr size_t WS_XN = 32 * MiB, WS_U = 98 * MiB, WS_PO = 263 * MiB, WS_Y = 362 * MiB, WS_MIX = 395 * MiB, WS_H = 461 * MiB, WS_END = 725 * MiB;
constexpr int LDS_BYTES = 135168;
constexpr int MISC_OFF = 131072;

struct Params {
    const float *x_prompt, *x_sample, *cache_k, *cache_v, *state_conv, *state_ssm, *w_in, *w_out, *conv_w, *conv_b, *dt_bias, *a_log, *d_skip, *ssm_norm,
                *norm_mix, *norm_mlp, *w_up, *w_down, *norm_final;
    float* out; unsigned char* ws; int ph_lo, ph_hi;
};

__device__ __forceinline__ unsigned f2bf(float f) { unsigned u = __float_as_uint(f); return (u + 0x7fffu + ((u >> 16) & 1u)) >> 16; }
__device__ __forceinline__ unsigned pk2(float lo, float hi) { return f2bf(lo) | (f2bf(hi) << 16); }
__device__ __forceinline__ float bf2f(unsigned b) { return __uint_as_float(b << 16); }
__device__ __forceinline__ float bflo(unsigned w) { return __uint_as_float(w << 16); }
__device__ __forceinline__ float bfhi(unsigned w) { return __uint_as_float(w & 0xffff0000u); }
__device__ __forceinline__ float wave_sum(float v) {
#pragma unroll
    for (int o = 1; o < 64; o <<= 1) v += __shfl_xor(v, o);
    return v;
}
__device__ __forceinline__ float silu(float v) { return v * __builtin_amdgcn_rcpf(1.f + __expf(-v)); }
__device__ __forceinline__ float softplus(float v) { return v > 20.f ? v : log1pf(__expf(v)); }
#define MFMA32(a, b, c) __builtin_amdgcn_mfma_f32_32x32x16_bf16((a), (b), (c), 0, 0, 0)
__device__ __forceinline__ int crow(int r, int hh) { return (r & 3) + 8 * (r >> 2) + 4 * hh; }
__device__ __forceinline__ bf16x8 pack8(const f32x16& X, int s) {
    u32x4 w; w.x = pk2(X[8 * s + 0], X[8 * s + 1]); w.y = pk2(X[8 * s + 2], X[8 * s + 3]); w.z = pk2(X[8 * s + 4], X[8 * s + 5]); w.w = pk2(X[8 * s + 6], X[8 * s + 7]);
    return __builtin_bit_cast(bf16x8, w);
}
__device__ __forceinline__ bf16x8 ld2x8(const LAS bf16_t* p0, const LAS bf16_t* p1) {
    u32x2 a = *(const LAS u32x2*)p0, b = *(const LAS u32x2*)p1; u32x4 w; w.x = a.x; w.y = a.y; w.z = b.x; w.w = b.y; return __builtin_bit_cast(bf16x8, w);
}

__device__ __forceinline__ void transpose_item(const float* W, int ldw, int K, bf16_t* WT, LAS float* scr, int kb, int nb, int lane) {
    const int k0 = 64 * kb, n0 = 32 * nb;
#pragma unroll 8
    for (int i = 0; i < 32; ++i) { const int kk = 2 * i + (lane >> 5); scr[kk * 33 + (lane & 31)] = W[(size_t)(k0 + kk) * ldw + n0 + (lane & 31)]; }
    asm volatile("s_waitcnt lgkmcnt(0)" ::: "memory");
    const int c = lane & 7;
#pragma unroll
    for (int j = 0; j < 4; ++j) { const int n = (lane >> 3) + 8 * j; const LAS float* s = scr + (8 * c) * 33 + n;
        u32x4 o; o.x = pk2(s[0 * 33], s[1 * 33]); o.y = pk2(s[2 * 33], s[3 * 33]); o.z = pk2(s[4 * 33], s[5 * 33]); o.w = pk2(s[6 * 33], s[7 * 33]);
        *(u32x4*)(WT + (size_t)(n0 + n) * K + k0 + 8 * c) = o; }
    asm volatile("s_waitcnt lgkmcnt(0)" ::: "memory");
}

__device__ __forceinline__ void phase0(const Params& p, LAS unsigned char* lds) {
    const int tid = threadIdx.x, lane = tid & 63, wave = tid >> 6;
    const int G = gridDim.x, gw = blockIdx.x * 8 + wave, NGW = G * 8;
    unsigned char* ws = p.ws;
    LAS float* swA = (LAS float*)(lds + 69632);
    LAS float* swB = swA + 4096;
    for (int i = tid; i < 8192; i += 512) { const int k = i >> 3, e = i & 7; const float v = p.w_in[(size_t)k * NIN + NU + e];
        const int pos = ((k >> 8) * 4 + (k & 3)) * 64 + ((k >> 2) & 63); if (e < 4) swA[pos * 4 + e] = v; else swB[pos * 4 + e - 4] = v; }
    { float* rope = (float*)(ws + WS_ROPE);
      for (int i = blockIdx.x * 512 + tid; i < 2056 * 8; i += G * 512) { const int pi = i >> 3, f = i & 7; const float pos = pi < 2048 ? (float)pi : (float)(8192 + pi - 2048);
          const float inv = powf(500000.0f, -(float)(2 * f) / 16.0f); const float ang = pos * inv; rope[pi * 16 + f] = (float)cos((double)ang); rope[pi * 16 + 8 + f] = (float)sin((double)ang); } }
    { LAS float* scr = (LAS float*)(lds + wave * 8704);
      constexpr int I_IN = 16 * 80, I_OUT = 16 * 32, I_UP = 16 * 128, I_DN = 64 * 32, NIT = I_IN + I_OUT + I_UP + I_DN;
      for (int it = gw; it < NIT; it += NGW) { int r = it;
          if (r < I_IN) { transpose_item(p.w_in, NIN, 1024, (bf16_t*)(ws + WS_WIN), scr, r / 80, r % 80, lane); continue; } r -= I_IN;
          if (r < I_OUT) { transpose_item(p.w_out, 1024, 1024, (bf16_t*)(ws + WS_WOUT), scr, r / 32, r % 32, lane); continue; } r -= I_OUT;
          if (r < I_UP) { transpose_item(p.w_up, 4096, 1024, (bf16_t*)(ws + WS_WUP), scr, r / 128, r % 128, lane); continue; } r -= I_UP;
          transpose_item(p.w_down, 1024, 4096, (bf16_t*)(ws + WS_WDN), scr, r / 32, r % 32, lane); } }
    __syncthreads();
    { bf16_t* XN = (bf16_t*)(ws + WS_XN); float* DT = (float*)(ws + WS_DT);
      for (int row = gw; row < M; row += NGW) {
          const float* xr = row < MP ? p.x_prompt + (size_t)row * D : p.x_sample + (size_t)(row - MP) * D;
          f32x4 v[4]; float s = 0.f;
#pragma unroll
          for (int j = 0; j < 4; ++j) { v[j] = ((const f32x4*)xr)[lane + 64 * j]; s += (v[j].x * v[j].x + v[j].y * v[j].y) + (v[j].z * v[j].z + v[j].w * v[j].w); }
          s = wave_sum(s); const float rstd = 1.0f / sqrtf(s * (1.0f / 1024.0f) + EPS);
          float d0 = 0.f, d1 = 0.f, d2 = 0.f, d3 = 0.f, d4 = 0.f, d5 = 0.f, d6 = 0.f, d7 = 0.f;
#pragma unroll
          for (int j = 0; j < 4; ++j) {
              const f32x4 g = ((const f32x4*)p.norm_mix)[lane + 64 * j];
              const f32x4 xn = v[j] * rstd * g;
              u32x2 o; o.x = pk2(xn.x, xn.y); o.y = pk2(xn.z, xn.w);
              *(u32x2*)(XN + (size_t)row * D + 4 * lane + 256 * j) = o;
#pragma unroll
              for (int e = 0; e < 4; ++e) { const int pos = (j * 4 + e) * 64 + lane; const f32x4 wa = *(const LAS f32x4*)(swA + pos * 4), wb = *(const LAS f32x4*)(swB + pos * 4);
                  const float xe = xn[e]; d0 += xe * wa.x; d1 += xe * wa.y; d2 += xe * wa.z; d3 += xe * wa.w; d4 += xe * wb.x; d5 += xe * wb.y; d6 += xe * wb.z; d7 += xe * wb.w; }
          }
          d0 = wave_sum(d0); d1 = wave_sum(d1); d2 = wave_sum(d2); d3 = wave_sum(d3); d4 = wave_sum(d4); d5 = wave_sum(d5); d6 = wave_sum(d6); d7 = wave_sum(d7);
          if (lane == 0) { *(f32x4*)(DT + (size_t)row * 8) = (f32x4){d0, d1, d2, d3}; *(f32x4*)(DT + (size_t)row * 8 + 4) = (f32x4){d4, d5, d6, d7}; }
      } }
}

struct EpiIn {
    static constexpr bool PERM = true, AFTER_DRAIN = false;
    bf16_t* U; float* out; const float* rope;
    __device__ __forceinline__ void operator()(const f32x4 (&acc)[2][2][4][2], const Unit& u, int wr, int wc, int fr, int fq) const {
        const int pn = u.pn;
#pragma unroll
        for (int ai = 0; ai < 2; ++ai)
#pragma unroll
            for (int m = 0; m < 4; ++m) {
                const int row = u.pm * 256 + ai * 128 + wr * 64 + m * 16 + fr;
                const bool isp = row < MP; const int rs = row - MP;
                const int pidx = isp ? (row & 2047) : (2048 + (rs & 7));
#pragma unroll
                for (int bj = 0; bj < 2; ++bj) {
                    const int c0 = pn * 256 + bj * 128 + wc * 32 + 8 * fq;
                    f32x4 v0 = acc[ai][bj][m][0], v1 = acc[ai][bj][m][1];
                    if (pn <= 2 && !(wc & 1)) {
                        f32x4 p0, p1;
                        p0.x = __shfl_xor(v0.x, 16); p0.y = __shfl_xor(v0.y, 16); p0.z = __shfl_xor(v0.z, 16); p0.w = __shfl_xor(v0.w, 16);
                        p1.x = __shfl_xor(v1.x, 16); p1.y = __shfl_xor(v1.y, 16); p1.z = __shfl_xor(v1.z, 16); p1.w = __shfl_xor(v1.w, 16);
                        if (fq < 2) {
                            const f32x4 c0v = *(const f32x4*)(rope + pidx * 16), c1v = *(const f32x4*)(rope + pidx * 16 + 4);
                            f32x4 s0v = *(const f32x4*)(rope + pidx * 16 + 8), s1v = *(const f32x4*)(rope + pidx * 16 + 12);
                            if (fq == 0) { s0v = -s0v; s1v = -s1v; }
                            v0 = v0 * c0v + p0 * s0v; v1 = v1 * c1v + p1 * s1v;
                        }
                    }
                    if (pn < 2) { v0 = v0 * 0.125f; v1 = v1 * 0.125f; }
                    u32x4 w; w.x = pk2(v0.x, v0.y); w.y = pk2(v0.z, v0.w); w.z = pk2(v1.x, v1.y); w.w = pk2(v1.z, v1.w);
                    *(u32x4*)(U + (size_t)row * NU + c0) = w;
                    if (pn == 2 || pn == 3) {
                        const size_t orow = isp ? (size_t)row : (size_t)((rs >> 3) * WC + 2040 + (rs & 7));
                        const size_t base = isp ? (pn == 2 ? O_KP : O_VP) : (pn == 2 ? O_KS : O_VS);
                        float* o = out + base + orow * 256 + (c0 - pn * 256);
                        *(f32x4*)o = v0; *(f32x4*)(o + 4) = v1;
                    }
                    if (pn >= 6) {
                        if (isp) { const int s = row & 2047; if (s >= 2045) { float* o = out + O_CP + (size_t)((row >> 11) * 3 + (s - 2045)) * 1024 + (c0 - 1536); *(f32x4*)o = v0; *(f32x4*)(o + 4) = v1; } }
                        else { const int t = rs & 7; if (t >= 5) { float* o = out + O_CS + (size_t)((rs >> 3) * 3 + (t - 5)) * 1024 + (c0 - 1536); *(f32x4*)o = v0; *(f32x4*)(o + 4) = v1; } }
                    }
                }
            }
    }
};
struct EpiOut {
    static constexpr bool PERM = true, AFTER_DRAIN = false;
    const float* xp; const float* xs; float* h1; bf16_t* HG; const float* gm; float* ssq; bf16_t* H1;
    __device__ __forceinline__ void operator()(const f32x4 (&acc)[2][2][4][2], const Unit& u, int wr, int wc, int fr, int fq) const {
#pragma unroll
        for (int ai = 0; ai < 2; ++ai)
#pragma unroll
            for (int m = 0; m < 4; ++m) {
                const int row = u.pm * 256 + ai * 128 + wr * 64 + m * 16 + fr;
                const float* xr = row < MP ? xp + (size_t)row * D : xs + (size_t)(row - MP) * D;
                float ss = 0.f;
#pragma unroll
                for (int bj = 0; bj < 2; ++bj) {
                    const int c0 = u.pn * 256 + bj * 128 + wc * 32 + 8 * fq;
                    const f32x4 a0 = *(const f32x4*)(xr + c0) + acc[ai][bj][m][0], a1 = *(const f32x4*)(xr + c0 + 4) + acc[ai][bj][m][1];
                    if (row >= MP) { *(f32x4*)(h1 + (size_t)row * D + c0) = a0; *(f32x4*)(h1 + (size_t)row * D + c0 + 4) = a1; }
                    else { u32x4 wh; wh.x = pk2(a0.x, a0.y); wh.y = pk2(a0.z, a0.w); wh.z = pk2(a1.x, a1.y); wh.w = pk2(a1.z, a1.w); *(u32x4*)(H1 + (size_t)row * D + c0) = wh; }
                    const f32x4 g0 = *(const f32x4*)(gm + c0), g1 = *(const f32x4*)(gm + c0 + 4);
                    u32x4 w; w.x = pk2(a0.x * g0.x, a0.y * g0.y); w.y = pk2(a0.z * g0.z, a0.w * g0.w); w.z = pk2(a1.x * g1.x, a1.y * g1.y); w.w = pk2(a1.z * g1.z, a1.w * g1.w);
                    *(u32x4*)(HG + (size_t)row * D + c0) = w;
                    ss += (a0.x * a0.x + a0.y * a0.y) + (a0.z * a0.z + a0.w * a0.w) + (a1.x * a1.x + a1.y * a1.y) + (a1.z * a1.z + a1.w * a1.w);
                }
                ss += __shfl_xor(ss, 16); ss += __shfl_xor(ss, 32);
                if (fq == 0) atomicAdd(ssq + row, ss);
            }
    }
};
struct EpiUp {
    static constexpr bool PERM = true, AFTER_DRAIN = false;
    const float* ssq; bf16_t* H;
    __device__ __forceinline__ void operator()(const f32x4 (&acc)[2][2][4][2], const Unit& u, int wr, int wc, int fr, int fq) const {
#pragma unroll
        for (int ai = 0; ai < 2; ++ai)
#pragma unroll
            for (int m = 0; m < 4; ++m) {
                const int row = u.pm * 256 + ai * 128 + wr * 64 + m * 16 + fr;
                const float rstd = 1.0f / sqrtf(ssq[row] * (1.0f / 1024.0f) + EPS);
#pragma unroll
                for (int bj = 0; bj < 2; ++bj) {
                    const int c0 = u.pn * 256 + bj * 128 + wc * 32 + 8 * fq;
                    f32x4 a0 = acc[ai][bj][m][0] * rstd, a1 = acc[ai][bj][m][1] * rstd;
                    a0.x = fmaxf(a0.x, 0.f); a0.y = fmaxf(a0.y, 0.f); a0.z = fmaxf(a0.z, 0.f); a0.w = fmaxf(a0.w, 0.f);
                    a1.x = fmaxf(a1.x, 0.f); a1.y = fmaxf(a1.y, 0.f); a1.z = fmaxf(a1.z, 0.f); a1.w = fmaxf(a1.w, 0.f);
                    a0 = a0 * a0; a1 = a1 * a1;
                    u32x4 w; w.x = pk2(a0.x, a0.y); w.y = pk2(a0.z, a0.w); w.z = pk2(a1.x, a1.y); w.w = pk2(a1.z, a1.w);
                    *(u32x4*)(H + (size_t)row * FF + c0) = w;
                }
            }
    }
};
struct EpiDown {
    static constexpr bool PERM = true, AFTER_DRAIN = false;
    const bf16_t* H1; bf16_t* H2;
    __device__ __forceinline__ void operator()(const f32x4 (&acc)[2][2][4][2], const Unit& u, int wr, int wc, int fr, int fq) const {
#pragma unroll
        for (int ai = 0; ai < 2; ++ai)
#pragma unroll
            for (int m = 0; m < 4; ++m) {
                const int row = u.pm * 256 + ai * 128 + wr * 64 + m * 16 + fr;
#pragma unroll
                for (int bj = 0; bj < 2; ++bj) {
                    const int c0 = u.pn * 256 + bj * 128 + wc * 32 + 8 * fq;
                    const u32x4 hq = *(const u32x4*)(H1 + (size_t)row * D + c0);
                    const f32x4 a0 = (f32x4){bflo(hq.x), bfhi(hq.x), bflo(hq.y), bfhi(hq.y)} + acc[ai][bj][m][0], a1 = (f32x4){bflo(hq.z), bfhi(hq.z), bflo(hq.w), bfhi(hq.w)} + acc[ai][bj][m][1];
                    u32x4 w; w.x = pk2(a0.x, a0.y); w.y = pk2(a0.z, a0.w); w.z = pk2(a1.x, a1.y); w.w = pk2(a1.z, a1.w);
                    *(u32x4*)(H2 + (size_t)row * D + c0) = w;
                }
            }
    }
};
struct EpiDownAtomic {
    static constexpr bool PERM = true, AFTER_DRAIN = false;
    float* part;
    __device__ __forceinline__ void operator()(const f32x4 (&acc)[2][2][4][2], const Unit& u, int wr, int wc, int fr, int fq) const {
        float* pb = part + (size_t)(u.k0 >> 10) * MS * D;
#pragma unroll
        for (int ai = 0; ai < 2; ++ai)
#pragma unroll
            for (int m = 0; m < 4; ++m) {
                const int row = u.pm * 256 + ai * 128 + wr * 64 + m * 16 + fr;
#pragma unroll
                for (int bj = 0; bj < 2; ++bj) {
                    const int c0 = u.pn * 256 + bj * 128 + wc * 32 + 8 * fq;
                    float* hp = pb + (size_t)row * D + c0;
                    *(f32x4*)hp = acc[ai][bj][m][0]; *(f32x4*)(hp + 4) = acc[ai][bj][m][1];
                }
            }
    }
};
struct SplitOrder {
    int G, c;
    __device__ bool next(int i, Unit& u) const { const int L = i * G + c; if (L >= 64) return false; const int kp = L >> 4, t = L & 15; u.pm = t >> 2; u.pn = t & 3; u.k0 = kp * 1024; return true; }
    __device__ __forceinline__ void a_ready(const Unit&) const {}
    __device__ __forceinline__ void done(const Unit&) const {}
};

constexpr int PB = 136;
__device__ __forceinline__ void ssd_prompt_unit(const Params& p, LAS unsigned char* lds, int b, int h) {
    const int tid = threadIdx.x, lane = tid & 63, w = __builtin_amdgcn_readfirstlane(tid >> 6), r32 = lane & 31, hh = lane >> 5;
    const int g = h >> 2;
    const bf16_t* U = (const bf16_t*)(p.ws + WS_U); const float* DT = (const float*)(p.ws + WS_DT); bf16_t* Y = (bf16_t*)(p.ws + WS_Y);
    LAS bf16_t* sB = (LAS bf16_t*)lds;
    LAS bf16_t* sC = sB + 128 * PB;
    LAS bf16_t* sXT = sC + 128 * PB;
    LAS bf16_t* sXW = sXT + 64 * PB;
    LAS bf16_t* sH = sXW + 64 * PB;
    LAS float* sA = (LAS float*)(sH + 64 * PB);
    LAS float* sDt = sA + 128;
    const float Ah = -__expf(p.a_log[h]), dtb = p.dt_bias[h], Dsk = p.d_skip[h];
    __syncthreads();
    for (int i = tid; i < 64 * PB / 2; i += 512) ((LAS unsigned*)sH)[i] = 0u;
    const int oct = tid % 40, tl = tid / 40;
    int ucol; if (oct < 8) ucol = 1536 + h * 64 + 8 * oct; else if (oct < 24) ucol = 2048 + g * 128 + 8 * (oct - 8); else ucol = 2304 + g * 128 + 8 * (oct - 24);
    LAS float* sCW = sDt + 128;
    for (int i = tid; i < 1600; i += 512) { const int oc = i / 40, k = i % 40;
        const int ch = (oc < 8) ? (h * 64 + 8 * oc) : (oc < 24) ? (512 + g * 128 + 8 * (oc - 8)) : (768 + g * 128 + 8 * (oc - 24));
        sCW[i] = (k < 32) ? p.conv_w[(k >> 3) * 1024 + ch + (k & 7)] : p.conv_b[ch + k - 32]; }
    __syncthreads();
    f32x16 hacc;
#pragma unroll
    for (int r = 0; r < 16; ++r) hacc[r] = 0.f;
    const int bi = w >> 1, pt = w & 1, nt = w >> 1;
    const int tb = tl * 11;
    u32x4 pw1, pw2, pw3, nx[4];
    pw1 = pw2 = pw3 = (u32x4){0u, 0u, 0u, 0u};
#pragma unroll
    for (int k = 0; k < 4; ++k) nx[k] = (u32x4){0u, 0u, 0u, 0u};
    if (tid < 480) {
        const bf16_t* upn = U + ((size_t)b * SEQ + tb) * NU + ucol;
        if (tb >= 3) { pw1 = *(const u32x4*)(upn - 3 * (ptrdiff_t)NU); pw2 = *(const u32x4*)(upn - 2 * (ptrdiff_t)NU); pw3 = *(const u32x4*)(upn - (ptrdiff_t)NU); }
#pragma unroll
        for (int k = 0; k < 4; ++k) if (tb + k < 128) nx[k] = *(const u32x4*)(upn + (size_t)k * NU);
    }
    float dtn = 0.f, dtn0 = 0.f;
    if (w < 2) { dtn = DT[((size_t)b * SEQ + 64 * w + lane) * 8 + h]; dtn0 = DT[((size_t)b * SEQ + lane) * 8 + h]; }
    for (int c = 0; c < 16; ++c) {
        const int t0 = c * 128; const size_t rowb = (size_t)b * SEQ + t0;
        if (w < 2) {
            const int t = 64 * w + lane;
            const float dtv = softplus(dtn + dtb);
            float sc = dtv * Ah;
#pragma unroll
            for (int o = 1; o < 64; o <<= 1) { const float n = __shfl_up(sc, o); if (lane >= o) sc += n; }
            if (w == 1) { const float d0 = softplus(dtn0 + dtb); sc += wave_sum(d0 * Ah); }
            sA[t] = sc; sDt[t] = dtv;
            if (c < 15) { dtn = DT[(rowb + 128 + t) * 8 + h]; dtn0 = DT[(rowb + 128 + lane) * 8 + h]; }
        }
        if (HY_T1 && tid < 480) {
            float cw[4][8], cb[8];
#pragma unroll
            for (int tp = 0; tp < 4; ++tp) { const f32x4 a = *(const LAS f32x4*)(sCW + oct * 40 + tp * 8), cc = *(const LAS f32x4*)(sCW + oct * 40 + tp * 8 + 4);
                cw[tp][0] = a.x; cw[tp][1] = a.y; cw[tp][2] = a.z; cw[tp][3] = a.w; cw[tp][4] = cc.x; cw[tp][5] = cc.y; cw[tp][6] = cc.z; cw[tp][7] = cc.w; }
            { const f32x4 a = *(const LAS f32x4*)(sCW + oct * 40 + 32), cc = *(const LAS f32x4*)(sCW + oct * 40 + 36);
              cb[0] = a.x; cb[1] = a.y; cb[2] = a.z; cb[3] = a.w; cb[4] = cc.x; cb[5] = cc.y; cb[6] = cc.z; cb[7] = cc.w; }
            u32x4 win[4];
            const bf16_t* up = U + ((size_t)b * SEQ + t0 + tb) * NU + ucol;
            win[1] = pw1; win[2] = pw2; win[3] = pw3;
#pragma unroll 1
            for (int i = 0; i < 11; ++i) {
                const int t = tb + i; if (t >= 128) break;
                win[0] = win[1]; win[1] = win[2]; win[2] = win[3]; win[3] = nx[0];
                nx[0] = nx[1]; nx[1] = nx[2]; nx[2] = nx[3];
                if (t + 4 < 128 && i + 4 < 11) nx[3] = *(const u32x4*)(up + (size_t)(i + 4) * NU);
                float o[8];
#pragma unroll
                for (int e = 0; e < 8; ++e) o[e] = cb[e];
#pragma unroll
                for (int tp = 0; tp < 4; ++tp) {
                    const u32x4 q = win[tp];
                    o[0] += cw[tp][0] * bflo(q.x); o[1] += cw[tp][1] * bfhi(q.x); o[2] += cw[tp][2] * bflo(q.y); o[3] += cw[tp][3] * bfhi(q.y);
                    o[4] += cw[tp][4] * bflo(q.z); o[5] += cw[tp][5] * bfhi(q.z); o[6] += cw[tp][6] * bflo(q.w); o[7] += cw[tp][7] * bfhi(q.w);
                }
#pragma unroll
                for (int e = 0; e < 8; ++e) o[e] = silu(o[e]);
                if (oct < 8) {
#pragma unroll
                    for (int e = 0; e < 8; ++e) sXT[(8 * oct + e) * PB + t] = (bf16_t)f2bf(o[e]);
                } else {
                    u32x4 wv; wv.x = pk2(o[0], o[1]); wv.y = pk2(o[2], o[3]); wv.z = pk2(o[4], o[5]); wv.w = pk2(o[6], o[7]);
                    LAS bf16_t* dst = (oct < 24) ? (sB + t * PB + 8 * (oct - 8)) : (sC + t * PB + 8 * (oct - 24));
                    *(LAS u32x4*)dst = wv;
                }
            }
        }
        __syncthreads();
        { const float aL = sA[127];
#pragma unroll
          for (int k = 0; k < 2; ++k) { const int idx = tid + 512 * k, pp = idx >> 4, to = (idx & 15) * 8;
              const u32x4 q = *(const LAS u32x4*)(sXT + pp * PB + to);
              float wgt[8];
#pragma unroll
              for (int e = 0; e < 8; ++e) wgt[e] = __expf(aL - sA[to + e]) * sDt[to + e];
              u32x4 o; o.x = pk2(bflo(q.x) * wgt[0], bfhi(q.x) * wgt[1]); o.y = pk2(bflo(q.y) * wgt[2], bfhi(q.y) * wgt[3]);
              o.z = pk2(bflo(q.z) * wgt[4], bfhi(q.z) * wgt[5]); o.w = pk2(bflo(q.w) * wgt[6], bfhi(q.w) * wgt[7]);
              *(LAS u32x4*)(sXW + pp * PB + to) = o; } }
        __syncthreads();
        if (tid < 480 && c < 15) {
            const bf16_t* upn = U + ((size_t)b * SEQ + t0 + 128 + tb) * NU + ucol;
            pw1 = *(const u32x4*)(upn - 3 * (ptrdiff_t)NU); pw2 = *(const u32x4*)(upn - 2 * (ptrdiff_t)NU); pw3 = *(const u32x4*)(upn - (ptrdiff_t)NU);
#pragma unroll
            for (int k = 0; k < 4; ++k) if (tb + k < 128) nx[k] = *(const u32x4*)(upn + (size_t)k * NU);
        }
        if (HY_T2) {
            f32x16 yd, yo;
#pragma unroll
            for (int r = 0; r < 16; ++r) { yd[r] = 0.f; yo[r] = 0.f; }
            const int icol = 32 * bi + r32; const float a_i = sA[icol];
            for (int bj = 0; bj <= bi; ++bj) {
                f32x16 X;
#pragma unroll
                for (int r = 0; r < 16; ++r) X[r] = 0.f;
#pragma unroll 4
                for (int s = 0; s < 8; ++s) {
                    const bf16x8 Af = *(const LAS bf16x8*)(sB + (32 * bj + r32) * PB + 16 * s + 8 * hh);
                    const bf16x8 Bf = *(const LAS bf16x8*)(sC + icol * PB + 16 * s + 8 * hh);
                    X = MFMA32(Af, Bf, X);
                }
#pragma unroll
                for (int r = 0; r < 16; ++r) { const int j = 32 * bj + crow(r, hh); const float f = __expf(a_i - sA[j]) * sDt[j]; X[r] = (j <= icol) ? X[r] * f : 0.f; }
#pragma unroll
                for (int s = 0; s < 2; ++s) {
                    const LAS bf16_t* xp_ = sXT + (32 * pt + r32) * PB + 32 * bj + 16 * s + 4 * hh;
                    const bf16x8 Af = ld2x8(xp_, xp_ + 8);
                    yd = MFMA32(Af, pack8(X, s), yd);
                }
            }
            u32x2 zz4[4];
#pragma unroll
            for (int q4 = 0; q4 < 4; ++q4) zz4[q4] = *(const u32x2*)(U + (rowb + icol) * NU + 1024 + h * 64 + 32 * pt + 8 * q4 + 4 * hh);
#pragma unroll 4
            for (int s = 0; s < 8; ++s) {
                const bf16x8 Af = *(const LAS bf16x8*)(sH + (32 * pt + r32) * PB + 16 * s + 8 * hh);
                const bf16x8 Bf = *(const LAS bf16x8*)(sC + icol * PB + 16 * s + 8 * hh);
                yo = MFMA32(Af, Bf, yo);
            }
            const float ea = __expf(a_i);
            const size_t row = rowb + icol;
#pragma unroll
            for (int q4 = 0; q4 < 4; ++q4) {
                const int p0 = 32 * pt + 8 * q4 + 4 * hh;
                const u32x2 zz = zz4[q4];
                float yv[4];
#pragma unroll
                for (int e = 0; e < 4; ++e) { const float xv = bf2f(sXT[(p0 + e) * PB + icol]); yv[e] = yd[4 * q4 + e] + ea * yo[4 * q4 + e] + Dsk * xv; }
                yv[0] *= silu(bflo(zz.x)); yv[1] *= silu(bfhi(zz.x)); yv[2] *= silu(bflo(zz.y)); yv[3] *= silu(bfhi(zz.y));
                u32x2 o; o.x = pk2(yv[0], yv[1]); o.y = pk2(yv[2], yv[3]);
                *(u32x2*)(Y + row * 512 + h * 64 + p0) = o;
            }
        }
        if (HY_T3) {
            const float dec = __expf(sA[127]);
#pragma unroll
            for (int r = 0; r < 16; ++r) hacc[r] *= dec;
#pragma unroll 2
            for (int s = 0; s < 8; ++s) {
                const bf16x8 Af = *(const LAS bf16x8*)(sXW + (32 * pt + r32) * PB + 16 * s + 8 * hh);
                const LAS bf16_t* bp = sB + (16 * s + 8 * hh) * PB + 32 * nt + r32;
                u32x4 wv; wv.x = (unsigned)bp[0] | ((unsigned)bp[PB] << 16); wv.y = (unsigned)bp[2 * PB] | ((unsigned)bp[3 * PB] << 16);
                wv.z = (unsigned)bp[4 * PB] | ((unsigned)bp[5 * PB] << 16); wv.w = (unsigned)bp[6 * PB] | ((unsigned)bp[7 * PB] << 16);
                hacc = MFMA32(Af, __builtin_bit_cast(bf16x8, wv), hacc);
            }
        }
        __syncthreads();
#pragma unroll
        for (int r = 0; r < 16; ++r) sH[(32 * pt + crow(r, hh)) * PB + 32 * nt + r32] = (bf16_t)f2bf(hacc[r]);
    }
    float* so = p.out + O_SP + (size_t)(b * 8 + h) * 64 * 128;
#pragma unroll
    for (int r = 0; r < 16; ++r) so[(32 * pt + crow(r, hh)) * 128 + 32 * nt + r32] = hacc[r];
}

constexpr int VP = 264, KP = 72;
__device__ __forceinline__ void attn_prompt_unit(const Params& p, LAS unsigned char* lds, int unit) {
    const int tid = threadIdx.x, lane = tid & 63, w = __builtin_amdgcn_readfirstlane(tid >> 6), r32 = lane & 31, hh = lane >> 5;
    const int g = unit >> 10, rr = unit & 1023, b = rr >> 6, r2 = rr & 63, kvh = r2 >> 4, zn = r2 & 15;
    const int dsh = 2 * g, d = 1 << dsh;
    const int nbl = 16 >> dsh;
    const int z = zn / nbl, n = zn % nbl;
    const bf16_t* U = (const bf16_t*)(p.ws + WS_U);
    bf16_t* PO = (bf16_t*)(p.ws + WS_PO) + (size_t)g * M * 512; float* LSE = (float*)(p.ws + WS_LSE) + (size_t)g * M * 8;
    LAS bf16_t* sK = (LAS bf16_t*)lds;
    LAS bf16_t* sVT = sK + 256 * KP;
    const size_t rowb = (size_t)b * SEQ;
    const int sub0 = 128 * (n - 1);
    __syncthreads();
#pragma unroll
    for (int k = 0; k < 4; ++k) {
        const int idx = tid + 512 * k, key = idx >> 3, oc = idx & 7;
        const int js = sub0 + key;
        u32x4 q = (u32x4){0u, 0u, 0u, 0u}, kq = q;
        if (js >= 0) { const bf16_t* rp = U + (rowb + z + (size_t)d * js) * NU + kvh * 64 + 8 * oc; kq = *(const u32x4*)(rp + 512); q = *(const u32x4*)(rp + 768); }
        *(LAS u32x4*)(sK + key * KP + 8 * oc) = kq;
        LAS bf16_t* dst = sVT + (8 * oc) * VP + (key ^ (oc << 2));
        dst[0] = (bf16_t)(q.x & 0xffffu); dst[VP] = (bf16_t)(q.x >> 16); dst[2 * VP] = (bf16_t)(q.y & 0xffffu); dst[3 * VP] = (bf16_t)(q.y >> 16);
        dst[4 * VP] = (bf16_t)(q.z & 0xffffu); dst[5 * VP] = (bf16_t)(q.z >> 16); dst[6 * VP] = (bf16_t)(q.w & 0xffffu); dst[7 * VP] = (bf16_t)(q.w >> 16);
    }
    const int w3 = w & 3, hq = kvh * 2 + (w >> 2);
    const int qsub = 128 * n + 32 * w3 + r32;
    const size_t qrow = rowb + z + (size_t)d * qsub;
    bf16x8 qf[4];
#pragma unroll
    for (int s = 0; s < 4; ++s) qf[s] = *(const bf16x8*)(U + qrow * NU + hq * 64 + 16 * s + 8 * hh);
    __syncthreads();
    f32x16 S[5];
    const int iq = 128 + 32 * w3 + r32;
#pragma unroll
    for (int kk = 0; kk < 5; ++kk) {
        const int kb = w3 + kk;
        const bool live = (n > 0) || (kb >= 4);
#pragma unroll
        for (int r = 0; r < 16; ++r) S[kk][r] = 0.f;
        if (live) {
            const LAS bf16_t* kp = sK + (32 * kb + r32) * KP + 8 * hh;
#pragma unroll
            for (int s = 0; s < 4; ++s) { const bf16x8 kf = *(const LAS bf16x8*)(kp + 16 * s); S[kk] = MFMA32(kf, qf[s], S[kk]); }
        }
#pragma unroll
        for (int r = 0; r < 16; ++r) { const int jb = 32 * kb + crow(r, hh); const int dist = iq - jb; const bool ok = live && dist >= 0 && dist <= 128; S[kk][r] = ok ? S[kk][r] : -1e30f; }
    }
    float mx = -1e30f;
#pragma unroll
    for (int kk = 0; kk < 5; ++kk)
#pragma unroll
        for (int r = 0; r < 16; ++r) mx = fmaxf(mx, S[kk][r]);
    mx = fmaxf(mx, __shfl_xor(mx, 32));
    float l = 0.f;
#pragma unroll
    for (int kk = 0; kk < 5; ++kk)
#pragma unroll
        for (int r = 0; r < 16; ++r) { const float e = __expf(S[kk][r] - mx); S[kk][r] = e; l += e; }
    l += __shfl_xor(l, 32);
    f32x16 O0, O1;
#pragma unroll
    for (int r = 0; r < 16; ++r) { O0[r] = 0.f; O1[r] = 0.f; }
#pragma unroll
    for (int kk = 0; kk < 5; ++kk) {
        const int kb = w3 + kk;
#pragma unroll
        for (int s = 0; s < 2; ++s) {
            const bf16x8 pf = pack8(S[kk], s);
            const int k0 = 32 * kb + 16 * s + 4 * hh, sw0 = (r32 >> 3) << 2, sw1 = sw0 + 16;
            const LAS bf16_t* v0 = sVT + r32 * VP;
            const LAS bf16_t* v1 = v0 + 32 * VP;
            O0 = MFMA32(ld2x8(v0 + (k0 ^ sw0), v0 + ((k0 + 8) ^ sw0)), pf, O0);
            O1 = MFMA32(ld2x8(v1 + (k0 ^ sw1), v1 + ((k0 + 8) ^ sw1)), pf, O1);
        }
    }
    const float il = 1.0f / l;
    bf16_t* po = PO + qrow * 512 + hq * 64;
#pragma unroll
    for (int q4 = 0; q4 < 4; ++q4) {
        const int d0 = 8 * q4 + 4 * hh;
        u32x2 o; o.x = pk2(O0[4 * q4] * il, O0[4 * q4 + 1] * il); o.y = pk2(O0[4 * q4 + 2] * il, O0[4 * q4 + 3] * il);
        *(u32x2*)(po + d0) = o;
        o.x = pk2(O1[4 * q4] * il, O1[4 * q4 + 1] * il); o.y = pk2(O1[4 * q4 + 2] * il, O1[4 * q4 + 3] * il);
        *(u32x2*)(po + 32 + d0) = o;
    }
    if (hh == 0) LSE[qrow * 8 + hq] = mx + __logf(l);
}

__device__ __forceinline__ void attn_sample_item(const Params& p, LAS unsigned char* lds, int item) {
    const int tid = threadIdx.x, lane = tid & 63, t = __builtin_amdgcn_readfirstlane(tid >> 6);
    const int g = item % 3, r = item / 3, kvh = r & 3, b = r >> 2;
    const int d = 1 << (2 * g);
    const int sub = lane >> 4, dl = lane & 15;
    const bf16_t* U = (const bf16_t*)(p.ws + WS_U);
    const size_t row = (size_t)MP + b * 8 + t;
    float q0[4], q1[4];
    { const u32x2 a = *(const u32x2*)(U + row * NU + (kvh * 2) * 64 + 4 * dl), c = *(const u32x2*)(U + row * NU + (kvh * 2 + 1) * 64 + 4 * dl);
      q0[0] = bflo(a.x); q0[1] = bfhi(a.x); q0[2] = bflo(a.y); q0[3] = bfhi(a.y); q1[0] = bflo(c.x); q1[1] = bfhi(c.x); q1[2] = bflo(c.y); q1[3] = bfhi(c.y); }
    const float* ck = p.cache_k + (size_t)b * WC * 256 + kvh * 64 + 4 * dl;
    const float* cv = p.cache_v + (size_t)b * WC * 256 + kvh * 64 + 4 * dl;
    const float* nk = p.out + O_KS + (size_t)b * WC * 256 + kvh * 64 + 4 * dl;
    const float* nv = p.out + O_VS + (size_t)b * WC * 256 + kvh * 64 + 4 * dl;
    float m0 = -1e30f, m1 = -1e30f, l0 = 0.f, l1 = 0.f; f32x4 o0 = (f32x4){0.f, 0.f, 0.f, 0.f}, o1 = o0;
#pragma unroll 1
    for (int bt = 0; bt < 3; ++bt) {
        f32x4 kv[11], vv[11];
#pragma unroll
        for (int u = 0; u < 11; ++u) { const int j = 4 * (bt * 11 + u) + sub, jc = j < 128 ? j : 128; const int idx = WC + t - d * jc;
            const size_t off = (idx < WC) ? (size_t)idx * 256 : (size_t)(idx - 8) * 256;
            kv[u] = *(const f32x4*)(((idx < WC) ? ck : nk) + off); vv[u] = *(const f32x4*)(((idx < WC) ? cv : nv) + off); }
        float a0[11], a1[11]; float bm0 = -1e30f, bm1 = -1e30f;
#pragma unroll
        for (int u = 0; u < 11; ++u) {
            const int j = 4 * (bt * 11 + u) + sub;
            float x0 = q0[0] * kv[u].x + q0[1] * kv[u].y + q0[2] * kv[u].z + q0[3] * kv[u].w;
            float x1 = q1[0] * kv[u].x + q1[1] * kv[u].y + q1[2] * kv[u].z + q1[3] * kv[u].w;
#pragma unroll
            for (int o = 1; o < 16; o <<= 1) { x0 += __shfl_xor(x0, o); x1 += __shfl_xor(x1, o); }
            if (j > 128) { x0 = -1e30f; x1 = -1e30f; }
            a0[u] = x0; a1[u] = x1; bm0 = fmaxf(bm0, x0); bm1 = fmaxf(bm1, x1);
        }
        bm0 = fmaxf(bm0, __shfl_xor(bm0, 16)); bm0 = fmaxf(bm0, __shfl_xor(bm0, 32)); bm1 = fmaxf(bm1, __shfl_xor(bm1, 16)); bm1 = fmaxf(bm1, __shfl_xor(bm1, 32));
        const float mn0 = fmaxf(m0, bm0), mn1 = fmaxf(m1, bm1); const float sc0 = __expf(m0 - mn0), sc1 = __expf(m1 - mn1);
        l0 *= sc0; l1 *= sc1; o0 = o0 * sc0; o1 = o1 * sc1; m0 = mn0; m1 = mn1;
#pragma unroll
        for (int u = 0; u < 11; ++u) {
            const int j = 4 * (bt * 11 + u) + sub;
            const float e0 = (j <= 128) ? __expf(a0[u] - m0) : 0.f, e1 = (j <= 128) ? __expf(a1[u] - m1) : 0.f;
            l0 += e0; l1 += e1; o0 += vv[u] * e0; o1 += vv[u] * e1;
        }
    }
#pragma unroll
    for (int o = 16; o < 64; o <<= 1) { l0 += __shfl_xor(l0, o); l1 += __shfl_xor(l1, o);
        o0.x += __shfl_xor(o0.x, o); o0.y += __shfl_xor(o0.y, o); o0.z += __shfl_xor(o0.z, o); o0.w += __shfl_xor(o0.w, o);
        o1.x += __shfl_xor(o1.x, o); o1.y += __shfl_xor(o1.y, o); o1.z += __shfl_xor(o1.z, o); o1.w += __shfl_xor(o1.w, o); }
    if (sub == 0) {
        bf16_t* PO = (bf16_t*)(p.ws + WS_PO) + (size_t)g * M * 512; float* LSE = (float*)(p.ws + WS_LSE) + (size_t)g * M * 8;
        const float i0 = 1.0f / l0, i1 = 1.0f / l1;
        u32x2 o; o.x = pk2(o0.x * i0, o0.y * i0); o.y = pk2(o0.z * i0, o0.w * i0); *(u32x2*)(PO + row * 512 + (kvh * 2) * 64 + 4 * dl) = o;
        o.x = pk2(o1.x * i1, o1.y * i1); o.y = pk2(o1.z * i1, o1.w * i1); *(u32x2*)(PO + row * 512 + (kvh * 2 + 1) * 64 + 4 * dl) = o;
        if (dl == 0) { LSE[row * 8 + kvh * 2] = m0 + __logf(l0); LSE[row * 8 + kvh * 2 + 1] = m1 + __logf(l1); }
    }
}

__device__ __forceinline__ void ssd_sample_item(const Params& p, LAS unsigned char* lds, int item) {
    const int tid = threadIdx.x, b = item >> 3, h = item & 7, g = h >> 2;
    const bf16_t* U = (const bf16_t*)(p.ws + WS_U); const float* DT = (const float*)(p.ws + WS_DT); bf16_t* Y = (bf16_t*)(p.ws + WS_Y);
    LAS float* sx = (LAS float*)lds;
    LAS float* sBn = sx + 512;
    LAS float* sCn = sBn + 1024;
    __syncthreads();
    for (int i = tid; i < 8 * 320; i += 512) {
        const int t = i / 320, c = i % 320;
        int ucol; if (c < 64) ucol = 1536 + h * 64 + c; else if (c < 192) ucol = 2048 + g * 128 + (c - 64); else ucol = 2304 + g * 128 + (c - 192);
        const int ch = ucol - 1536;
        float o = p.conv_b[ch];
#pragma unroll
        for (int tp = 0; tp < 4; ++tp) { const int r = t + tp;
            const float v = (r < 3) ? p.state_conv[((size_t)b * 3 + r) * 1024 + ch] : bf2f(U[((size_t)MP + b * 8 + (r - 3)) * NU + ucol]);
            o += p.conv_w[tp * 1024 + ch] * v; }
        o = silu(o);
        if (c < 64) sx[t * 64 + c] = o; else if (c < 192) sBn[t * 128 + c - 64] = o; else sCn[t * 128 + c - 192] = o;
    }
    __syncthreads();
    const int pp = tid >> 3, n0 = (tid & 7) * 16;
    const float Ah = -__expf(p.a_log[h]), dtb = p.dt_bias[h], Dsk = p.d_skip[h];
    const float* s0 = p.state_ssm + ((size_t)(b * 8 + h) * 64 + pp) * 128 + n0;
    float st[16];
#pragma unroll
    for (int k = 0; k < 4; ++k) { const f32x4 v = *(const f32x4*)(s0 + 4 * k); st[4 * k] = v.x; st[4 * k + 1] = v.y; st[4 * k + 2] = v.z; st[4 * k + 3] = v.w; }
    float dts[8], zs[8];
#pragma unroll
    for (int t = 0; t < 8; ++t) { const size_t row = (size_t)MP + b * 8 + t; dts[t] = DT[row * 8 + h]; zs[t] = bf2f(U[row * NU + 1024 + h * 64 + pp]); }
#pragma unroll
    for (int t = 0; t < 8; ++t) {
        const size_t row = (size_t)MP + b * 8 + t;
        const float dtv = softplus(dts[t] + dtb), dA = __expf(dtv * Ah);
        const float xv = sx[t * 64 + pp], xdt = xv * dtv;
        float y = 0.f;
#pragma unroll
        for (int k = 0; k < 16; ++k) { st[k] = st[k] * dA + xdt * sBn[t * 128 + n0 + k]; y += sCn[t * 128 + n0 + k] * st[k]; }
        y += __shfl_xor(y, 1); y += __shfl_xor(y, 2); y += __shfl_xor(y, 4);
        if ((tid & 7) == 0) {
            const float zv = zs[t];
            Y[row * 512 + h * 64 + pp] = (bf16_t)f2bf((y + Dsk * xv) * silu(zv));
        }
    }
    float* so = p.out + O_SS + ((size_t)(b * 8 + h) * 64 + pp) * 128 + n0;
#pragma unroll
    for (int k = 0; k < 4; ++k) *(f32x4*)(so + 4 * k) = (f32x4){st[4 * k], st[4 * k + 1], st[4 * k + 2], st[4 * k + 3]};
}


__device__ __forceinline__ void copy_item(const Params& p, int item) {
    const int tid = threadIdx.x, pr = item >> 2, part = item & 3, tns = pr >> 7, b = pr & 127;
    const f32x4* src = (const f32x4*)((tns ? p.cache_v : p.cache_k) + (size_t)b * WC * 256 + 8 * 256) + part * 32640 + tid;
    f32x4* dst = (f32x4*)(p.out + (tns ? O_VS : O_KS) + (size_t)b * WC * 256) + part * 32640 + tid;
    constexpr int NI = 32640;
    f32x4 va[8], vb[8];
#pragma unroll
    for (int u = 0; u < 8; ++u) { const int i = 512 * u; if (i + tid < NI) va[u] = __builtin_nontemporal_load(src + i); }
#pragma unroll 1
    for (int r = 0; r < 8; r += 2) {
#pragma unroll
        for (int u = 0; u < 8; ++u) { const int i = (r + 1) * 4096 + 512 * u; if (i + tid < NI) vb[u] = __builtin_nontemporal_load(src + i); }
#pragma unroll
        for (int u = 0; u < 8; ++u) { const int i = r * 4096 + 512 * u; if (i + tid < NI) __builtin_nontemporal_store(va[u], dst + i); }
#pragma unroll
        for (int u = 0; u < 8; ++u) { const int i = (r + 2) * 4096 + 512 * u; if (r + 2 < 8 && i + tid < NI) va[u] = __builtin_nontemporal_load(src + i); }
#pragma unroll
        for (int u = 0; u < 8; ++u) { const int i = (r + 1) * 4096 + 512 * u; if (i + tid < NI) __builtin_nontemporal_store(vb[u], dst + i); }
    }
}
constexpr int N_COPY = 1024;
#ifndef HY_CQ1
#define HY_CQ1 0
#define HY_CQ3 0
#define HY_CQ4 0
#define HY_CQ5 0
#endif
constexpr int N_COPY_P2 = N_COPY;
__device__ __forceinline__ void copy_quota(const Params& p, LAS unsigned char* lds, int quota) {
    unsigned* cctr = (unsigned*)(p.ws + WS_CTL) + 32;
    volatile LAS int* sItem = (volatile LAS int*)(lds + MISC_OFF);
    for (int q = 0; q < quota; ++q) {
        __syncthreads();
        if (threadIdx.x == 0) sItem[0] = (int)atomicAdd(cctr, 1u);
        __syncthreads();
        const int it = sItem[0];
        if (it >= N_COPY) break;
        copy_item(p, it);
    }
}
__device__ __forceinline__ bool short_block(int nwg) { const int G = gridDim.x, c = blockIdx.x; return (nwg - c + G - 1) / G < (nwg + G - 1) / G; }
constexpr int N_SSDP = 128, N_ATTP = 3072, N_SSDS = 1024, N_ATTS = 1536, N_P2 = N_SSDP + N_ATTP + N_SSDS + N_ATTS + N_COPY_P2;
__device__ __forceinline__ void phase2(const Params& p, LAS unsigned char* lds, int cidx, int ilo = 0, int ihi = 1 << 30) {
    unsigned* ctr = (unsigned*)(p.ws + WS_CTL) + cidx;
    volatile LAS int* sItem = (volatile LAS int*)(lds + MISC_OFF);
    if (cidx == 0) {
        const int G = (int)gridDim.x;
        if ((G & 7) == 0 && G >= 128) { const int xcd = (int)blockIdx.x & 7, slot = (int)blockIdx.x >> 3; if (slot < 16) { const int u = xcd * 16 + slot; ssd_prompt_unit(p, lds, u >> 3, u & 7); } }
        else { for (int u = (int)blockIdx.x; u < N_SSDP; u += G) ssd_prompt_unit(p, lds, u >> 3, u & 7); }
    }
    for (;;) {
        __syncthreads();
        if (threadIdx.x == 0) sItem[0] = (int)atomicAdd(ctr, 1u);
        __syncthreads();
        int it = sItem[0] + ilo + (cidx == 0 ? N_SSDP : 0);
        if (it >= N_P2 || it >= ihi) break;
        if (it < N_SSDP) { if (HY_P2MASK & 1) ssd_prompt_unit(p, lds, it >> 3, it & 7); continue; } it -= N_SSDP;
        { const int grp = it / 13, pos = it % 13;
          if (pos == 5 || pos == 12) { copy_item(p, 2 * grp + (pos == 12)); continue; }
          it = grp * 11 + (pos < 5 ? pos : pos - 1); }
        if (it < N_ATTS) { if (HY_P2MASK & 8) attn_sample_item(p, lds, it); continue; } it -= N_ATTS;
        if (it < N_SSDS) { if (HY_P2MASK & 4) ssd_sample_item(p, lds, it); continue; } it -= N_SSDS;
        if (HY_P2MASK & 2) attn_prompt_unit(p, lds, it);
    }
}

__device__ __forceinline__ void phase2b(const Params& p) {
    const int tid = threadIdx.x, lane = tid & 63, wave = tid >> 6, gw = blockIdx.x * 8 + wave, NGW = gridDim.x * 8;
    const bf16_t* PO = (const bf16_t*)(p.ws + WS_PO); const float* LSE = (const float*)(p.ws + WS_LSE); const bf16_t* Y = (const bf16_t*)(p.ws + WS_Y);
    bf16_t* MIX = (bf16_t*)(p.ws + WS_MIX);
    const f32x4 sn0 = *(const f32x4*)(p.ssm_norm + 8 * lane), sn1 = *(const f32x4*)(p.ssm_norm + 8 * lane + 4);
    const int hd = lane >> 3;
    for (int row0 = gw; row0 < M; row0 += 4 * NGW) {
        u32x4 a[4], c[4], e[4], yq[4]; float l0[4], l1[4], l2[4];
#pragma unroll
        for (int r = 0; r < 4; ++r) { const int row = row0 + r * NGW; if (row < M) {
            l0[r] = LSE[(size_t)row * 8 + hd]; l1[r] = LSE[((size_t)M + row) * 8 + hd]; l2[r] = LSE[((size_t)2 * M + row) * 8 + hd];
            a[r] = *(const u32x4*)(PO + (size_t)row * 512 + 8 * lane); c[r] = *(const u32x4*)(PO + ((size_t)M + row) * 512 + 8 * lane); e[r] = *(const u32x4*)(PO + ((size_t)2 * M + row) * 512 + 8 * lane);
            yq[r] = *(const u32x4*)(Y + (size_t)row * 512 + 8 * lane); } }
#pragma unroll
        for (int r = 0; r < 4; ++r) { const int row = row0 + r * NGW; if (row < M) {
            const float mx = fmaxf(l0[r], fmaxf(l1[r], l2[r])); float w0 = __expf(l0[r] - mx), w1 = __expf(l1[r] - mx), w2 = __expf(l2[r] - mx);
            const float iw = 1.0f / (w0 + w1 + w2); w0 *= iw; w1 *= iw; w2 *= iw;
            u32x4 o;
            o.x = pk2(w0 * bflo(a[r].x) + w1 * bflo(c[r].x) + w2 * bflo(e[r].x), w0 * bfhi(a[r].x) + w1 * bfhi(c[r].x) + w2 * bfhi(e[r].x));
            o.y = pk2(w0 * bflo(a[r].y) + w1 * bflo(c[r].y) + w2 * bflo(e[r].y), w0 * bfhi(a[r].y) + w1 * bfhi(c[r].y) + w2 * bfhi(e[r].y));
            o.z = pk2(w0 * bflo(a[r].z) + w1 * bflo(c[r].z) + w2 * bflo(e[r].z), w0 * bfhi(a[r].z) + w1 * bfhi(c[r].z) + w2 * bfhi(e[r].z));
            o.w = pk2(w0 * bflo(a[r].w) + w1 * bflo(c[r].w) + w2 * bflo(e[r].w), w0 * bfhi(a[r].w) + w1 * bfhi(c[r].w) + w2 * bfhi(e[r].w));
            *(u32x4*)(MIX + (size_t)row * 1024 + 8 * lane) = o;
            const u32x4 q = yq[r];
            float y[8] = {bflo(q.x), bfhi(q.x), bflo(q.y), bfhi(q.y), bflo(q.z), bfhi(q.z), bflo(q.w), bfhi(q.w)};
            float ss = 0.f;
#pragma unroll
            for (int k = 0; k < 8; ++k) ss += y[k] * y[k];
#pragma unroll
            for (int of = 1; of < 32; of <<= 1) ss += __shfl_xor(ss, of);
            const float rstd = 1.0f / sqrtf(ss * (1.0f / 256.0f) + EPS);
            u32x4 oy; oy.x = pk2(y[0] * rstd * sn0.x, y[1] * rstd * sn0.y); oy.y = pk2(y[2] * rstd * sn0.z, y[3] * rstd * sn0.w);
            oy.z = pk2(y[4] * rstd * sn1.x, y[5] * rstd * sn1.y); oy.w = pk2(y[6] * rstd * sn1.z, y[7] * rstd * sn1.w);
            *(u32x4*)(MIX + (size_t)row * 1024 + 512 + 8 * lane) = oy; } }
    }
}

__device__ __forceinline__ void phase6(const Params& p) {
    const int tid = threadIdx.x, lane = tid & 63, wave = tid >> 6, gw = blockIdx.x * 8 + wave, NGW = gridDim.x * 8;
    f32x4 g[4];
#pragma unroll
    for (int j = 0; j < 4; ++j) g[j] = ((const f32x4*)p.norm_final)[lane + 64 * j];
    for (int row0 = gw; row0 < M; row0 += 4 * NGW) {
        f32x4 v[4][4];
#pragma unroll
        for (int r = 0; r < 4; ++r) { const int row = row0 + r * NGW; if (row < M) {
            if (row < MP) {
                const u32x2* h2 = (const u32x2*)((const bf16_t*)(p.ws + WS_MIX) + (size_t)row * D);
#pragma unroll
                for (int j = 0; j < 4; ++j) { const u32x2 q = h2[lane + 64 * j]; v[r][j] = (f32x4){bflo(q.x), bfhi(q.x), bflo(q.y), bfhi(q.y)}; }
            } else {
                const f32x4* hr = (const f32x4*)(p.out + (size_t)row * D);
                const f32x4* pr = (const f32x4*)((const float*)(p.ws + WS_PO) + (size_t)(row - MP) * D);
#pragma unroll
                for (int j = 0; j < 4; ++j) { v[r][j] = hr[lane + 64 * j];
#pragma unroll
                    for (int k = 0; k < 4; ++k) v[r][j] += pr[(size_t)k * MS * D / 4 + lane + 64 * j]; }
            } } }
#pragma unroll
        for (int r = 0; r < 4; ++r) { const int row = row0 + r * NGW; if (row < M) {
            float s = 0.f;
#pragma unroll
            for (int j = 0; j < 4; ++j) s += (v[r][j].x * v[r][j].x + v[r][j].y * v[r][j].y) + (v[r][j].z * v[r][j].z + v[r][j].w * v[r][j].w);
            s = wave_sum(s);
            const float rstd = 1.0f / sqrtf(s * (1.0f / 1024.0f) + EPS);
            f32x4* hr = (f32x4*)(p.out + (size_t)row * D);
#pragma unroll
            for (int j = 0; j < 4; ++j) hr[lane + 64 * j] = v[r][j] * rstd * g[j]; } }
    }
}

#define XB_TMO      128
#define XB_XCNT(j)  (256  + 64 * (j))
#define XB_XSUB(j)  (1280 + 64 * (j))
#define XB_XGEN(j)  (2304 + 64 * (j))
#define XB_TOP      3328
#define XB_TOPGEN   3392
#define XCD_BAR_WORDS 3456
#define XB_SPIN_CAP (1u << 18)

__device__ __forceinline__ unsigned xb_ld(unsigned* p)              { return __hip_atomic_load(p, __ATOMIC_RELAXED, __HIP_MEMORY_SCOPE_AGENT); }
__device__ __forceinline__ unsigned xb_add(unsigned* p, unsigned v) { return __hip_atomic_fetch_add(p, v, __ATOMIC_RELAXED, __HIP_MEMORY_SCOPE_AGENT); }
__device__ __forceinline__ unsigned xb_xcc_id() { return (unsigned)__builtin_amdgcn_s_getreg((3 << 11) | 20) & 0xFu; }
#define XB_SPIN(cond, bar) do { unsigned _sp = 0; while (cond) { __builtin_amdgcn_s_sleep(1); \
    if ((++_sp & 255u) == 0u) { if (xb_ld(&(bar)[XB_TMO])) break; if (_sp > XB_SPIN_CAP) { atomicAdd(&(bar)[XB_TMO], 1u); break; } } } } while (0)

struct XcdBarrier {
    unsigned* bar; unsigned x;
    volatile LAS unsigned* st;
};

__device__ __forceinline__ XcdBarrier xcd_barrier_post(unsigned* bar, volatile LAS unsigned* st) {
    XcdBarrier b; b.bar = bar; b.x = xb_xcc_id(); b.st = st;
    if (threadIdx.x == 0) (void)xb_add(&bar[XB_XCNT(b.x)], 1u);
    return b;
}
__device__ __forceinline__ void xcd_barrier_complete(unsigned* bar, unsigned x, unsigned& nloc, unsigned& nx) {
    const unsigned G = gridDim.x * gridDim.y * gridDim.z;
    unsigned sum, cnt, mine, sp = 0u;
    for (;;) {
        sum = 0u; cnt = 0u; mine = 0u;
#pragma unroll
        for (unsigned j = 0; j < 16; ++j) { const unsigned c = xb_ld(&bar[XB_XCNT(j)]); sum += c; cnt += (c > 0u) ? 1u : 0u; mine = (j == x) ? c : mine; }
        if (sum == G) break;
        __builtin_amdgcn_s_sleep(1);
        if ((++sp & 255u) == 0u) { if (xb_ld(&bar[XB_TMO])) break; if (sp > XB_SPIN_CAP) { atomicAdd(&bar[XB_TMO], 1u); break; } }
    }
    nloc = mine > 0u ? mine : 1u; nx = cnt > 0u ? cnt : 1u;
}

__device__ __forceinline__ void xcd_barrier(const XcdBarrier& b) {
    asm volatile("s_waitcnt vmcnt(0)" ::: "memory");
    __syncthreads();
    if (threadIdx.x == 0) {
        unsigned* bar = b.bar;
        __builtin_amdgcn_s_waitcnt(0);
        unsigned nloc = b.st[0], nx = b.st[1];
        if (nloc == 0u) { xcd_barrier_complete(bar, b.x, nloc, nx); b.st[0] = nloc; b.st[1] = nx; }
        const unsigned old = xb_add(&bar[XB_XSUB(b.x)], 1u);
        const unsigned gen = old / nloc;
        if (old + 1u == (gen + 1u) * nloc) {
            __builtin_amdgcn_fence(__ATOMIC_RELEASE, "agent");
            asm volatile("s_waitcnt vmcnt(0)" ::: "memory");
            const unsigned og = xb_add(&bar[XB_TOP], 1u);
            const unsigned tg = og / nx;
            if (og + 1u == (tg + 1u) * nx) xb_add(&bar[XB_TOPGEN], 1u);
            else XB_SPIN(xb_ld(&bar[XB_TOPGEN]) == tg, bar);
            __builtin_amdgcn_fence(__ATOMIC_ACQUIRE, "agent");
            xb_add(&bar[XB_XGEN(b.x)], 1u);
            asm volatile("s_waitcnt vmcnt(0)" ::: "memory");
        } else {
            XB_SPIN(xb_ld(&bar[XB_XGEN(b.x)]) == gen, bar);
            __builtin_amdgcn_fence(__ATOMIC_ACQUIRE, "agent");
            asm volatile("s_waitcnt vmcnt(0)" ::: "memory");
        }
    }
    __syncthreads();
}


__global__ void __launch_bounds__(512, 2) hymba_fwd(Params p) {
    extern __shared__ __attribute__((aligned(16))) unsigned char lds_raw[];
    LAS unsigned char* lds = (LAS unsigned char*)lds_raw;
    cg::grid_group grid = cg::this_grid();
    unsigned char* ws = p.ws;
    float* ssq1 = (float*)(ws + WS_CTL + 4096); float* ssq2 = ssq1 + M;
    const int lo = p.ph_lo, hi = p.ph_hi;
    volatile LAS unsigned* xst = (volatile LAS unsigned*)(lds + MISC_OFF + 64);
    if (threadIdx.x < 2) xst[threadIdx.x] = 0u;
    __syncthreads();
    XcdBarrier xbar = xcd_barrier_post((unsigned*)(ws + WS_CTL + 524288), xst);
#define IN(k) (((HY_MASK >> (k)) & 1) && lo <= (k) && (k) < hi)
#define SEAM(k) do { if (IN(k) && IN((k) + 1)) { if (lo < 0) grid.sync(); else xcd_barrier(xbar); } } while (0)
    if (IN(0)) { phase0(p, lds); if (HY_DUP == 0) { grid.sync(); phase0(p, lds); } } SEAM(0);
    if (IN(1)) {
        pg8::Gemm gm{(const bf16_t*)(ws + WS_XN), (const bf16_t*)(ws + WS_WIN), M, NU, D, D}; pg8::StaticOrder S; S.init(M, NU, (int)gridDim.x, (int)blockIdx.x);
        EpiIn E{(bf16_t*)(ws + WS_U), p.out, (const float*)(ws + WS_ROPE)};
        pg8::gemm_phase<EpiIn, pg8::StaticOrder, true, true>(lds, gm, S, E);
        if (HY_DUP == 1) { grid.sync(); pg8::gemm_phase<EpiIn, pg8::StaticOrder, true, true>(lds, gm, S, E); }
        if (HY_DUP == 1) { grid.sync(); pg8::gemm_phase<EpiIn, pg8::StaticOrder, true, true>(lds, gm, S, E); }
        if (short_block((M / 256) * (NU / 256))) copy_quota(p, lds, HY_CQ1);
    } SEAM(1);
    if (IN(2)) { phase2(p, lds, 0); if (HY_DUP == 2) { grid.sync(); phase2(p, lds, 16, HY_DLO, HY_DHI); } } SEAM(2);
    if (IN(3)) { phase2b(p); if (HY_DUP == 3) { grid.sync(); phase2b(p); } } SEAM(3);
    if (IN(4)) {
        pg8::Gemm gm{(const bf16_t*)(ws + WS_MIX), (const bf16_t*)(ws + WS_WOUT), M, D, D, D}; pg8::StaticOrder S; S.init(M, D, (int)gridDim.x, (int)blockIdx.x);
        EpiOut E{p.x_prompt, p.x_sample, p.out, (bf16_t*)(ws + WS_XN), p.norm_mlp, ssq1, (bf16_t*)(ws + WS_U)};
        pg8::gemm_phase<EpiOut, pg8::StaticOrder, true, true>(lds, gm, S, E);
        if (short_block((M / 256) * (D / 256))) copy_quota(p, lds, HY_CQ3);
    } SEAM(4);
    if (IN(5)) {
        pg8::Gemm gm{(const bf16_t*)(ws + WS_XN), (const bf16_t*)(ws + WS_WUP), M, FF, D, D}; pg8::StaticOrder S; S.init(M, FF, (int)gridDim.x, (int)blockIdx.x);
        EpiUp E{ssq1, (bf16_t*)(ws + WS_H)};
        pg8::gemm_phase<EpiUp, pg8::StaticOrder, true, true>(lds, gm, S, E);
        if (HY_DUP == 5) { grid.sync(); pg8::gemm_phase<EpiUp, pg8::StaticOrder, true, true>(lds, gm, S, E); }
        if (short_block((M / 256) * (FF / 256))) copy_quota(p, lds, HY_CQ4);
    } SEAM(5);
    if (IN(6)) {
        { pg8::Gemm gm{(const bf16_t*)(ws + WS_H), (const bf16_t*)(ws + WS_WDN), MP, D, FF, FF}; pg8::StaticOrder S; S.init(MP, D, (int)gridDim.x, (int)blockIdx.x);
          EpiDown E{(const bf16_t*)(ws + WS_U), (bf16_t*)(ws + WS_MIX)};
          pg8::gemm_phase<EpiDown, pg8::StaticOrder, true, true>(lds, gm, S, E); }
        { pg8::Gemm gm{(const bf16_t*)(ws + WS_H) + (size_t)MP * FF, (const bf16_t*)(ws + WS_WDN), MS, D, 1024, FF}; SplitOrder S{(int)gridDim.x, (int)blockIdx.x};
          EpiDownAtomic E{(float*)(ws + WS_PO)};
          pg8::gemm_phase<EpiDownAtomic, SplitOrder, true, true>(lds, gm, S, E); }
    } SEAM(6);
    if (IN(7)) { phase6(p); }
    if (HY_DUP == 9) { for (int k = 0; k < 8; ++k) grid.sync(); }
#undef IN
#undef SEAM
}
}

extern "C" void kernel_launch(void* const* d_in, const int* in_sizes, int n_in, void* d_out, int out_size, void* d_ws, size_t ws_size, hipStream_t stream) {
    using namespace hy;
    static int grid = 0;
    if (grid == 0) {
        if (n_in != 19 || (size_t)out_size != O_END || ws_size < WS_END) { fprintf(stderr, "kernel_launch: unexpected shapes (n_in %d out %d ws %zu)\n", n_in, out_size, ws_size); grid = -1; return; }
        int dev = 0, cus = 0, per_cu = 0;
        (void)hipGetDevice(&dev); (void)hipDeviceGetAttribute(&cus, hipDeviceAttributeMultiprocessorCount, dev);
        if (hipFuncSetAttribute((const void*)hymba_fwd, hipFuncAttributeMaxDynamicSharedMemorySize, LDS_BYTES) != hipSuccess) { fprintf(stderr, "kernel_launch: hipFuncSetAttribute failed\n"); grid = -1; return; }
        if (hipOccupancyMaxActiveBlocksPerMultiprocessor(&per_cu, (const void*)hymba_fwd, 512, LDS_BYTES) != hipSuccess || per_cu < 1) { fprintf(stderr, "kernel_launch: occupancy query says %d\n", per_cu); per_cu = 1; }
        (void)hipGetLastError();
        grid = cus > 0 ? cus : 256;
    }
    if (grid < 0) return;
    (void)hipMemsetAsync((char*)d_ws + WS_CTL, 0, CTL_BYTES, stream);
    Params p{};
    p.x_prompt = (const float*)d_in[0]; p.x_sample = (const float*)d_in[1]; p.cache_k = (const float*)d_in[2]; p.cache_v = (const float*)d_in[3];
    p.state_conv = (const float*)d_in[4]; p.state_ssm = (const float*)d_in[5]; p.w_in = (const float*)d_in[6]; p.w_out = (const float*)d_in[7];
    p.conv_w = (const float*)d_in[8]; p.conv_b = (const float*)d_in[9]; p.dt_bias = (const float*)d_in[10]; p.a_log = (const float*)d_in[11];
    p.d_skip = (const float*)d_in[12]; p.ssm_norm = (const float*)d_in[13]; p.norm_mix = (const float*)d_in[14]; p.norm_mlp = (const float*)d_in[15];
    p.w_up = (const float*)d_in[16]; p.w_down = (const float*)d_in[17]; p.norm_final = (const float*)d_in[18];
    p.out = (float*)d_out; p.ws = (unsigned char*)d_ws;
#if HY_N_LAUNCHES == 1
    p.ph_lo = 0; p.ph_hi = 8;
    { void* args[] = {&p}; hipError_t e = hipLaunchCooperativeKernel((const void*)hymba_fwd, dim3(grid), dim3(512), args, LDS_BYTES, stream);
      if (e != hipSuccess) fprintf(stderr, "cooperative launch failed: %s (grid %d)\n", hipGetErrorString(e), grid); }
#else
    for (int ph = 0; ph < 8; ++ph) { p.ph_lo = ph; p.ph_hi = ph + 1; void* args[] = {&p};
        hipError_t e = hipLaunchCooperativeKernel((const void*)hymba_fwd, dim3(grid), dim3(512), args, LDS_BYTES, stream);
        if (e != hipSuccess) { fprintf(stderr, "cooperative launch %d failed: %s (grid %d)\n", ph, hipGetErrorString(e), grid); break; } }
#endif
}
```

```cpp
#include <hip/hip_runtime.h>
#include <hip/hip_cooperative_groups.h>
#include <cstdio>
#include <cstdint>
namespace cg = cooperative_groups;
namespace pg8 {
#define PG8_LAS __attribute__((address_space(3)))
typedef unsigned short bf16_t;
typedef short bf16x8 __attribute__((ext_vector_type(8)));
typedef float f32x4 __attribute__((ext_vector_type(4)));
typedef unsigned u32x4 __attribute__((ext_vector_type(4)));
constexpr int BM = 256, BK = 64, HALF = 128, HTB = HALF * BK * 2  , STAGE_BYTES = 8 * HTB, NXCD = 8, WGM = 8;

__host__ __device__ __forceinline__ int lds_byte(int r, int c) { const int st = (r >> 4) * 2 + (c >> 5), rr = r & 15, cc = c & 31, ob = rr * 64 + cc * 2; return st * 1024 + (ob ^ (((ob >> 9) & 1) << 5)); }
__host__ __device__ __forceinline__ void stage_rc(int b, int& R, int& C) { const int st = b / 1024, sb = b % 1024, swz = sb ^ (((sb >> 9) & 1) << 5); R = (st >> 1) * 16 + swz / 64; C = (st & 1) * 32 + (swz % 64) / 2; }
__host__ __device__ __forceinline__ int perm32(int rho) { const int n = rho >> 4, i = rho & 15; return 8 * (i >> 2) + 4 * n + (i & 3); }

struct Unit { int pm, pn, k0; };
struct Gemm { const bf16_t* A; const bf16_t* Bt; int M, N, K, ld; };

struct StaticOrder {
    int nM, nN, nwg, G, c;
    __host__ __device__ void init(int M, int N, int G_, int c_) { nM = M / BM; nN = N / BM; nwg = nM * nN; G = G_; c = c_; }
    __host__ __device__ bool next(int i, Unit& u) const {
        const long L = (long)i * G + c; if (L >= nwg) return false;
        int wgid = (int)L; { const int q = nwg / NXCD, r = nwg % NXCD, xcd = wgid % NXCD, off = wgid / NXCD; wgid = (xcd < r ? xcd * (q + 1) : r * (q + 1) + (xcd - r) * q) + off; }
        const int nig = WGM * nN, gid = wgid / nig, fm = gid * WGM, gsz = (nM - fm) < WGM ? (nM - fm) : WGM;
        u.pm = fm + ((wgid % nig) % gsz); u.pn = (wgid % nig) / gsz; u.k0 = 0; return true;
    }
    __device__ __forceinline__ void a_ready(const Unit&) const {}
    __device__ __forceinline__ void done(const Unit&) const {}
};
__device__ __forceinline__ unsigned cvt_pk_bf16(float lo, float hi) { unsigned r; asm volatile("v_cvt_pk_bf16_f32 %0, %1, %2" : "=v"(r) : "v"(lo), "v"(hi)); return r; }

template <class Epi, class Sched, bool ALIGN_EPI = false, bool SP2 = false>
__device__ __forceinline__ void gemm_phase(PG8_LAS unsigned char* lds, const Gemm g, const Sched& S, const Epi& E) {
    const int tid = threadIdx.x, wid = __builtin_amdgcn_readfirstlane(tid >> 6), lane = tid & 63, wr = wid >> 2, wc = wid & 3, fr = lane & 15, fq = lane >> 4;
    const int K = g.ld, nt = g.K / BK;
    unsigned voffA[2], voffB[2];
#pragma unroll
    for (int i = 0; i < 2; ++i) { int R, C; stage_rc(tid * 16 + i * 8192, R, C); const int Rb = Epi::PERM ? ((R & ~31) + perm32(R & 31)) : R;
        voffA[i] = (unsigned)(R * K + C) * 2u; voffB[i] = (unsigned)(Rb * K + C) * 2u; }
    const size_t kstep = (size_t)(BK * 2);
    const size_t hstep = (size_t)HALF * K * 2;
    const size_t tstep = 2 * hstep;
    const unsigned ldsw = (unsigned)wid * 1024u;
    const int aoff = lds_byte(wr * 64 + fr, fq * 8), boff = lds_byte(wc * 32 + fr, fq * 8);
#define PG8_SA(b, h) (((b) * 2 + (h)) * HTB)
#define PG8_SB(b, h) ((4 + (b) * 2 + (h)) * HTB)
#define PG8_STAGE(bufoff, gbase, voff) do { _Pragma("unroll") for (int _i = 0; _i < 2; ++_i) \
        __builtin_amdgcn_global_load_lds((const unsigned*)((const char*)(gbase) + (voff)[_i]), (PG8_LAS unsigned*)(lds + (bufoff) + ldsw + _i * 8192), 16, 0, 0); } while (0)
#define PG8_LDA(dst, b, h) do { _Pragma("unroll") for (int m = 0; m < 4; ++m) _Pragma("unroll") for (int k = 0; k < 2; ++k) dst[m][k] = *(const PG8_LAS bf16x8*)(lds + PG8_SA(b, h) + aoff + m * 2048 + k * 1024); } while (0)
#define PG8_LDB(dst, b, h) do { _Pragma("unroll") for (int n = 0; n < 2; ++n) _Pragma("unroll") for (int k = 0; k < 2; ++k) dst[n][k] = *(const PG8_LAS bf16x8*)(lds + PG8_SB(b, h) + boff + n * 2048 + k * 1024); } while (0)
#define PG8_MMA(ai, bj, At, Bt) do { __builtin_amdgcn_s_setprio(1); _Pragma("unroll") for (int m = 0; m < 4; ++m) _Pragma("unroll") for (int n = 0; n < 2; ++n) _Pragma("unroll") for (int k = 0; k < 2; ++k) \
        acc[ai][bj][m][n] = __builtin_amdgcn_mfma_f32_16x16x32_bf16(Bt[n][k], At[m][k], acc[ai][bj][m][n], 0, 0, 0); __builtin_amdgcn_s_setprio(0); } while (0)
#define PG8_WAIT_V(n) asm volatile("s_waitcnt vmcnt(" #n ")" ::: "memory")
#define PG8_WAIT_L(n) asm volatile("s_waitcnt lgkmcnt(" #n ")" ::: "memory")
#define PG8_BAR __builtin_amdgcn_s_barrier()
#define PG8_SCHED __builtin_amdgcn_sched_barrier(0)
    Unit cur, nxt; int ui = 0;
    if (!S.next(0, cur)) return;
    f32x4 acc[2][2][4][2];
#pragma unroll
    for (int a = 0; a < 2; ++a)
#pragma unroll
        for (int b = 0; b < 2; ++b)
#pragma unroll
            for (int m = 0; m < 4; ++m)
#pragma unroll
                for (int n = 0; n < 2; ++n) acc[a][b][m][n] = (f32x4){0.f, 0.f, 0.f, 0.f};
    bf16x8 At[4][2], B0[2][2], B1[2][2];
    const char* cA = (const char*)g.A + (size_t)cur.pm * tstep + (size_t)cur.k0 * 2; const char* cB = (const char*)g.Bt + (size_t)cur.pn * tstep + (size_t)cur.k0 * 2;
    S.a_ready(cur);
    if constexpr (SP2) {
        PG8_STAGE(PG8_SB(0, 0), cB, voffB); PG8_STAGE(PG8_SB(0, 1), cB + hstep, voffB); PG8_STAGE(PG8_SA(0, 0), cA, voffA); PG8_STAGE(PG8_SA(0, 1), cA + hstep, voffA);
        if (wr == 1) PG8_BAR;
        PG8_WAIT_V(2); PG8_BAR;
        PG8_STAGE(PG8_SB(1, 0), cB + kstep, voffB); PG8_STAGE(PG8_SA(1, 0), cA + kstep, voffA); PG8_STAGE(PG8_SB(1, 1), cB + hstep + kstep, voffB);
        PG8_WAIT_V(6); PG8_BAR;
    } else {
        PG8_STAGE(PG8_SB(0, 0), cB, voffB); PG8_STAGE(PG8_SA(0, 0), cA, voffA); PG8_STAGE(PG8_SB(0, 1), cB + hstep, voffB); PG8_STAGE(PG8_SA(0, 1), cA + hstep, voffA);
        if (wr == 1) PG8_BAR;
        PG8_WAIT_V(4); PG8_BAR;
        PG8_STAGE(PG8_SB(1, 0), cB + kstep, voffB); PG8_STAGE(PG8_SA(1, 0), cA + kstep, voffA); PG8_STAGE(PG8_SB(1, 1), cB + hstep + kstep, voffB);
        PG8_WAIT_V(6); PG8_BAR;
    }
    for (;;) {
        const bool has_next = S.next(ui + 1, nxt);
        const char* nA = has_next ? (const char*)g.A + (size_t)nxt.pm * tstep + (size_t)nxt.k0 * 2 : cA; const char* nB = has_next ? (const char*)g.Bt + (size_t)nxt.pn * tstep + (size_t)nxt.k0 * 2 : cB;
        for (int t = 0; t < nt; t += 2) {
            const bool last = (t == nt - 2);
            const char* a1 = cA + (size_t)(t + 1) * kstep;
            const char* a2 = last ? nA : cA + (size_t)(t + 2) * kstep; const char* b2 = last ? nB : cB + (size_t)(t + 2) * kstep;
            const char* a3 = a2 + kstep; const char* b3 = b2 + kstep;
            if (last && has_next) S.a_ready(nxt);
            if constexpr (SP2) {
            PG8_LDB(B0, 0, 0); PG8_LDB(B1, 0, 1); PG8_SCHED; PG8_LDA(At, 0, 0); PG8_STAGE(PG8_SA(1, 1), a1 + hstep, voffA);
            PG8_WAIT_V(8); PG8_WAIT_L(0); PG8_BAR; PG8_MMA(0, 0, At, B0); PG8_MMA(0, 1, At, B1); PG8_BAR; PG8_SCHED;
            PG8_LDA(At, 0, 1); PG8_STAGE(PG8_SB(0, 0), b2, voffB); PG8_STAGE(PG8_SB(0, 1), b2 + hstep, voffB); PG8_STAGE(PG8_SA(0, 0), a2, voffA);
            PG8_WAIT_V(8); PG8_WAIT_L(0); PG8_BAR; PG8_MMA(1, 0, At, B0); PG8_MMA(1, 1, At, B1); PG8_BAR; PG8_SCHED;
            PG8_LDB(B0, 1, 0); PG8_LDB(B1, 1, 1); PG8_SCHED; PG8_LDA(At, 1, 0); PG8_STAGE(PG8_SA(0, 1), a2 + hstep, voffA);
            PG8_WAIT_V(8); PG8_WAIT_L(0); PG8_BAR; PG8_MMA(0, 0, At, B0); PG8_MMA(0, 1, At, B1); PG8_BAR; PG8_SCHED;
            PG8_LDA(At, 1, 1); PG8_STAGE(PG8_SB(1, 0), b3, voffB); PG8_STAGE(PG8_SB(1, 1), b3 + hstep, voffB); PG8_STAGE(PG8_SA(1, 0), a3, voffA);
            PG8_WAIT_V(8); PG8_WAIT_L(0); PG8_BAR; PG8_MMA(1, 0, At, B0); PG8_MMA(1, 1, At, B1); PG8_BAR; PG8_SCHED;
            } else {
            PG8_LDB(B0, 0, 0); PG8_SCHED; PG8_LDA(At, 0, 0); PG8_STAGE(PG8_SA(1, 1), a1 + hstep, voffA);
            PG8_WAIT_L(8); PG8_BAR; PG8_WAIT_L(0); PG8_MMA(0, 0, At, B0); PG8_BAR; PG8_SCHED;
            PG8_LDB(B1, 0, 1); PG8_STAGE(PG8_SB(0, 0), b2, voffB);
            PG8_BAR; PG8_WAIT_L(0); PG8_MMA(0, 1, At, B1); PG8_BAR;
            PG8_LDA(At, 0, 1); PG8_STAGE(PG8_SA(0, 0), a2, voffA);
            PG8_BAR; PG8_WAIT_L(0); PG8_MMA(1, 0, At, B0); PG8_BAR; PG8_SCHED;
            PG8_STAGE(PG8_SB(0, 1), b2 + hstep, voffB);
            PG8_WAIT_V(6); PG8_BAR; PG8_MMA(1, 1, At, B1); PG8_BAR;
            PG8_LDB(B0, 1, 0); PG8_SCHED; PG8_LDA(At, 1, 0); PG8_STAGE(PG8_SA(0, 1), a2 + hstep, voffA);
            PG8_WAIT_L(8); PG8_BAR; PG8_WAIT_L(0); PG8_MMA(0, 0, At, B0); PG8_BAR; PG8_SCHED;
            PG8_LDB(B1, 1, 1); PG8_STAGE(PG8_SB(1, 0), b3, voffB);
            PG8_BAR; PG8_WAIT_L(0); PG8_MMA(0, 1, At, B1); PG8_BAR;
            PG8_LDA(At, 1, 1); PG8_STAGE(PG8_SA(1, 0), a3, voffA);
            PG8_BAR; PG8_WAIT_L(0); PG8_MMA(1, 0, At, B0); PG8_BAR; PG8_SCHED;
            PG8_STAGE(PG8_SB(1, 1), b3 + hstep, voffB);
            PG8_WAIT_V(6); PG8_BAR; PG8_MMA(1, 1, At, B1); PG8_BAR;
            }
        }
        if constexpr (ALIGN_EPI) { if (wr == 0) PG8_BAR; }
        if constexpr (!Epi::AFTER_DRAIN) { E(acc, cur, wr, wc, fr, fq); S.done(cur); }
        if (!has_next) break;
#pragma unroll
        for (int a = 0; a < 2; ++a)
#pragma unroll
            for (int b = 0; b < 2; ++b)
#pragma unroll
                for (int m = 0; m < 4; ++m)
#pragma unroll
                    for (int n = 0; n < 2; ++n) acc[a][b][m][n] = (f32x4){0.f, 0.f, 0.f, 0.f};
        cur = nxt; cA = nA; cB = nB; ++ui;
        if constexpr (ALIGN_EPI) { if (wr == 1) PG8_BAR; }
    }
    PG8_WAIT_V(0);
    if constexpr (!ALIGN_EPI) { if (wr == 0) PG8_BAR; }
    PG8_BAR;
    if constexpr (Epi::AFTER_DRAIN) { E.fused(acc, cur, wr, wc, fr, fq, lds, wid, lane); S.done(cur); }
#undef PG8_SA
#undef PG8_SB
#undef PG8_STAGE
#undef PG8_LDA
#undef PG8_LDB
#undef PG8_MMA
#undef PG8_WAIT_V
#undef PG8_WAIT_L
#undef PG8_BAR
#undef PG8_SCHED
}
}

#ifndef HY_MASK
#define HY_MASK 255
#endif
#ifndef HY_P2MASK
#define HY_P2MASK 15
#endif
#ifndef HY_T1
#define HY_T1 1
#endif
#ifndef HY_T2
#define HY_T2 1
#endif
#ifndef HY_T3
#define HY_T3 1
#endif
#ifndef HY_DUP
#define HY_DUP -1
#endif
#ifndef HY_DLO
#define HY_DLO 0
#define HY_DHI (1 << 30)
#endif
#ifndef HY_N_LAUNCHES
#define HY_N_LAUNCHES 1
#endif
namespace hy {
#define LAS __attribute__((address_space(3)))
using pg8::bf16_t; using pg8::bf16x8; using pg8::f32x4; using pg8::u32x4; using pg8::Unit;
typedef float f32x16 __attribute__((ext_vector_type(16)));
typedef unsigned u32x2 __attribute__((ext_vector_type(2)));

constexpr int MP = 32768, MS = 1024, M = MP + MS, D = 1024, NU = 2560, NIN = 2568, FF = 4096;
constexpr int SEQ = 2048, NBATCH = 16, DBATCH = 128, DSEQ = 8, WC = 2048;
constexpr float EPS = 1e-5f;
constexpr size_t O_YP = 0, O_YS = O_YP + (size_t)MP * D, O_KP = O_YS + (size_t)MS * D, O_VP = O_KP + (size_t)MP * 256,
                 O_CP = O_VP + (size_t)MP * 256, O_SP = O_CP + (size_t)NBATCH * 3 * 1024, O_KS = O_SP + (size_t)NBATCH * 8 * 64 * 128,
                 O_VS = O_KS + (size_t)DBATCH * WC * 256, O_CS = O_VS + (size_t)DBATCH * WC * 256, O_SS = O_CS + (size_t)DBATCH * 3 * 1024,
                 O_END = O_SS + (size_t)DBATCH * 8 * 64 * 128;
constexpr size_t MiB = 1u << 20;
constexpr size_t WS_CTL = 0, CTL_BYTES = 1 * MiB;
constexpr size_t WS_WIN = 1 * MiB, WS_WOUT = 6 * MiB, WS_WUP = 8 * MiB, WS_WDN = 16 * MiB, WS_ROPE = 24 * MiB, WS_DT = 25 * MiB, WS_LSE = 27 * MiB;
constexpr size_t WS_XN = 32 * MiB, WS_U = 98 * MiB, WS_PO = 263 * MiB, WS_Y = 362 * MiB, WS_MIX = 395 * MiB, WS_H = 461 * MiB, WS_END = 725 * MiB;
constexpr int LDS_BYTES = 135168;
constexpr int MISC_OFF = 131072;

struct Params {
    const float *x_prompt, *x_sample, *cache_k, *cache_v, *state_conv, *state_ssm, *w_in, *w_out, *conv_w, *conv_b, *dt_bias, *a_log, *d_skip, *ssm_norm,
                *norm_mix, *norm_mlp, *w_up, *w_down, *norm_final;
    float* out; unsigned char* ws; int ph_lo, ph_hi;
};

__device__ __forceinline__ unsigned f2bf(float f) { unsigned u = __float_as_uint(f); return (u + 0x7fffu + ((u >> 16) & 1u)) >> 16; }
__device__ __forceinline__ unsigned pk2(float lo, float hi) { return f2bf(lo) | (f2bf(hi) << 16); }
__device__ __forceinline__ float bf2f(unsigned b) { return __uint_as_float(b << 16); }
__device__ __forceinline__ float bflo(unsigned w) { return __uint_as_float(w << 16); }
__device__ __forceinline__ float bfhi(unsigned w) { return __uint_as_float(w & 0xffff0000u); }
__device__ __forceinline__ float wave_sum(float v) {
#pragma unroll
    for (int o = 1; o < 64; o <<= 1) v += __shfl_xor(v, o);
    return v;
}
__device__ __forceinline__ float silu(float v) { return v * __builtin_amdgcn_rcpf(1.f + __expf(-v)); }
__device__ __forceinline__ float softplus(float v) { return v > 20.f ? v : log1pf(__expf(v)); }
#define MFMA32(a, b, c) __builtin_amdgcn_mfma_f32_32x32x16_bf16((a), (b), (c), 0, 0, 0)
__device__ __forceinline__ int crow(int r, int hh) { return (r & 3) + 8 * (r >> 2) + 4 * hh; }
__device__ __forceinline__ bf16x8 pack8(const f32x16& X, int s) {
    u32x4 w; w.x = pk2(X[8 * s + 0], X[8 * s + 1]); w.y = pk2(X[8 * s + 2], X[8 * s + 3]); w.z = pk2(X[8 * s + 4], X[8 * s + 5]); w.w = pk2(X[8 * s + 6], X[8 * s + 7]);
    return __builtin_bit_cast(bf16x8, w);
}
__device__ __forceinline__ bf16x8 ld2x8(const LAS bf16_t* p0, const LAS bf16_t* p1) {
    u32x2 a = *(const LAS u32x2*)p0, b = *(const LAS u32x2*)p1; u32x4 w; w.x = a.x; w.y = a.y; w.z = b.x; w.w = b.y; return __builtin_bit_cast(bf16x8, w);
}

__device__ __forceinline__ void transpose_item(const float* W, int ldw, int K, bf16_t* WT, LAS float* scr, int kb, int nb, int lane) {
    const int k0 = 64 * kb, n0 = 32 * nb;
#pragma unroll 8
    for (int i = 0; i < 32; ++i) { const int kk = 2 * i + (lane >> 5); scr[kk * 33 + (lane & 31)] = W[(size_t)(k0 + kk) * ldw + n0 + (lane & 31)]; }
    asm volatile("s_waitcnt lgkmcnt(0)" ::: "memory");
    const int c = lane & 7;
#pragma unroll
    for (int j = 0; j < 4; ++j) { const int n = (lane >> 3) + 8 * j; const LAS float* s = scr + (8 * c) * 33 + n;
        u32x4 o; o.x = pk2(s[0 * 33], s[1 * 33]); o.y = pk2(s[2 * 33], s[3 * 33]); o.z = pk2(s[4 * 33], s[5 * 33]); o.w = pk2(s[6 * 33], s[7 * 33]);
        *(u32x4*)(WT + (size_t)(n0 + n) * K + k0 + 8 * c) = o; }
    asm volatile("s_waitcnt lgkmcnt(0)" ::: "memory");
}

__device__ __forceinline__ void phase0(const Params& p, LAS unsigned char* lds) {
    const int tid = threadIdx.x, lane = tid & 63, wave = tid >> 6;
    const int G = gridDim.x, gw = blockIdx.x * 8 + wave, NGW = G * 8;
    unsigned char* ws = p.ws;
    LAS float* swA = (LAS float*)(lds + 69632);
    LAS float* swB = swA + 4096;
    for (int i = tid; i < 8192; i += 512) { const int k = i >> 3, e = i & 7; const float v = p.w_in[(size_t)k * NIN + NU + e];
        const int pos = ((k >> 8) * 4 + (k & 3)) * 64 + ((k >> 2) & 63); if (e < 4) swA[pos * 4 + e] = v; else swB[pos * 4 + e - 4] = v; }
    { float* rope = (float*)(ws + WS_ROPE);
      for (int i = blockIdx.x * 512 + tid; i < 2056 * 8; i += G * 512) { const int pi = i >> 3, f = i & 7; const float pos = pi < 2048 ? (float)pi : (float)(8192 + pi - 2048);
          const float inv = powf(500000.0f, -(float)(2 * f) / 16.0f); const float ang = pos * inv; rope[pi * 16 + f] = (float)cos((double)ang); rope[pi * 16 + 8 + f] = (float)sin((double)ang); } }
    { LAS float* scr = (LAS float*)(lds + wave * 8704);
      constexpr int I_IN = 16 * 80, I_OUT = 16 * 32, I_UP = 16 * 128, I_DN = 64 * 32, NIT = I_IN + I_OUT + I_UP + I_DN;
      for (int it = gw; it < NIT; it += NGW) { int r = it;
          if (r < I_IN) { transpose_item(p.w_in, NIN, 1024, (bf16_t*)(ws + WS_WIN), scr, r / 80, r % 80, lane); continue; } r -= I_IN;
          if (r < I_OUT) { transpose_item(p.w_out, 1024, 1024, (bf16_t*)(ws + WS_WOUT), scr, r / 32, r % 32, lane); continue; } r -= I_OUT;
          if (r < I_UP) { transpose_item(p.w_up, 4096, 1024, (bf16_t*)(ws + WS_WUP), scr, r / 128, r % 128, lane); continue; } r -= I_UP;
          transpose_item(p.w_down, 1024, 4096, (bf16_t*)(ws + WS_WDN), scr, r / 32, r % 32, lane); } }
    __syncthreads();
    { bf16_t* XN = (bf16_t*)(ws + WS_XN); float* DT = (float*)(ws + WS_DT);
      for (int row = gw; row < M; row += NGW) {
          const float* xr = row < MP ? p.x_prompt + (size_t)row * D : p.x_sample + (size_t)(row - MP) * D;
          f32x4 v[4]; float s = 0.f;
#pragma unroll
          for (int j = 0; j < 4; ++j) { v[j] = ((const f32x4*)xr)[lane + 64 * j]; s += (v[j].x * v[j].x + v[j].y * v[j].y) + (v[j].z * v[j].z + v[j].w * v[j].w); }
          s = wave_sum(s); const float rstd = 1.0f / sqrtf(s * (1.0f / 1024.0f) + EPS);
          float d0 = 0.f, d1 = 0.f, d2 = 0.f, d3 = 0.f, d4 = 0.f, d5 = 0.f, d6 = 0.f, d7 = 0.f;
#pragma unroll
          for (int j = 0; j < 4; ++j) {
              const f32x4 g = ((const f32x4*)p.norm_mix)[lane + 64 * j];
              const f32x4 xn = v[j] * rstd * g;
              u32x2 o; o.x = pk2(xn.x, xn.y); o.y = pk2(xn.z, xn.w);
              *(u32x2*)(XN + (size_t)row * D + 4 * lane + 256 * j) = o;
#pragma unroll
              for (int e = 0; e < 4; ++e) { const int pos = (j * 4 + e) * 64 + lane; const f32x4 wa = *(const LAS f32x4*)(swA + pos * 4), wb = *(const LAS f32x4*)(swB + pos * 4);
                  const float xe = xn[e]; d0 += xe * wa.x; d1 += xe * wa.y; d2 += xe * wa.z; d3 += xe * wa.w; d4 += xe * wb.x; d5 += xe * wb.y; d6 += xe * wb.z; d7 += xe * wb.w; }
          }
          d0 = wave_sum(d0); d1 = wave_sum(d1); d2 = wave_sum(d2); d3 = wave_sum(d3); d4 = wave_sum(d4); d5 = wave_sum(d5); d6 = wave_sum(d6); d7 = wave_sum(d7);
          if (lane == 0) { *(f32x4*)(DT + (size_t)row * 8) = (f32x4){d0, d1, d2, d3}; *(f32x4*)(DT + (size_t)row * 8 + 4) = (f32x4){d4, d5, d6, d7}; }
      } }
}

struct EpiIn {
    static constexpr bool PERM = true, AFTER_DRAIN = false;
    bf16_t* U; float* out; const float* rope;
    __device__ __forceinline__ void operator()(const f32x4 (&acc)[2][2][4][2], const Unit& u, int wr, int wc, int fr, int fq) const {
        const int pn = u.pn;
#pragma unroll
        for (int ai = 0; ai < 2; ++ai)
#pragma unroll
            for (int m = 0; m < 4; ++m) {
                const int row = u.pm * 256 + ai * 128 + wr * 64 + m * 16 + fr;
                const bool isp = row < MP; const int rs = row - MP;
                const int pidx = isp ? (row & 2047) : (2048 + (rs & 7));
#pragma unroll
                for (int bj = 0; bj < 2; ++bj) {
                    const int c0 = pn * 256 + bj * 128 + wc * 32 + 8 * fq;
                    f32x4 v0 = acc[ai][bj][m][0], v1 = acc[ai][bj][m][1];
                    if (pn <= 2 && !(wc & 1)) {
                        f32x4 p0, p1;
                        p0.x = __shfl_xor(v0.x, 16); p0.y = __shfl_xor(v0.y, 16); p0.z = __shfl_xor(v0.z, 16); p0.w = __shfl_xor(v0.w, 16);
                        p1.x = __shfl_xor(v1.x, 16); p1.y = __shfl_xor(v1.y, 16); p1.z = __shfl_xor(v1.z, 16); p1.w = __shfl_xor(v1.w, 16);
                        if (fq < 2) {
                            const f32x4 c0v = *(const f32x4*)(rope + pidx * 16), c1v = *(const f32x4*)(rope + pidx * 16 + 4);
                            f32x4 s0v = *(const f32x4*)(rope + pidx * 16 + 8), s1v = *(const f32x4*)(rope + pidx * 16 + 12);
                            if (fq == 0) { s0v = -s0v; s1v = -s1v; }
                            v0 = v0 * c0v + p0 * s0v; v1 = v1 * c1v + p1 * s1v;
                        }
                    }
                    if (pn < 2) { v0 = v0 * 0.125f; v1 = v1 * 0.125f; }
                    u32x4 w; w.x = pk2(v0.x, v0.y); w.y = pk2(v0.z, v0.w); w.z = pk2(v1.x, v1.y); w.w = pk2(v1.z, v1.w);
                    *(u32x4*)(U + (size_t)row * NU + c0) = w;
                    if (pn == 2 || pn == 3) {
                        const size_t orow = isp ? (size_t)row : (size_t)((rs >> 3) * WC + 2040 + (rs & 7));
                        const size_t base = isp ? (pn == 2 ? O_KP : O_VP) : (pn == 2 ? O_KS : O_VS);
                        float* o = out + base + orow * 256 + (c0 - pn * 256);
                        *(f32x4*)o = v0; *(f32x4*)(o + 4) = v1;
                    }
                    if (pn >= 6) {
                        if (isp) { const int s = row & 2047; if (s >= 2045) { float* o = out + O_CP + (size_t)((row >> 11) * 3 + (s - 2045)) * 1024 + (c0 - 1536); *(f32x4*)o = v0; *(f32x4*)(o + 4) = v1; } }
                        else { const int t = rs & 7; if (t >= 5) { float* o = out + O_CS + (size_t)((rs >> 3) * 3 + (t - 5)) * 1024 + (c0 - 1536); *(f32x4*)o = v0; *(f32x4*)(o + 4) = v1; } }
                    }
                }
            }
    }
};
struct EpiOut {
    static constexpr bool PERM = true, AFTER_DRAIN = false;
    const float* xp; const float* xs; float* h1; bf16_t* HG; const float* gm; float* ssq; bf16_t* H1;
    __device__ __forceinline__ void operator()(const f32x4 (&acc)[2][2][4][2], const Unit& u, int wr, int wc, int fr, int fq) const {
#pragma unroll
        for (int ai = 0; ai < 2; ++ai)
#pragma unroll
            for (int m = 0; m < 4; ++m) {
                const int row = u.pm * 256 + ai * 128 + wr * 64 + m * 16 + fr;
                const float* xr = row < MP ? xp + (size_t)row * D : xs + (size_t)(row - MP) * D;
                float ss = 0.f;
#pragma unroll
                for (int bj = 0; bj < 2; ++bj) {
                    const int c0 = u.pn * 256 + bj * 128 + wc * 32 + 8 * fq;
                    const f32x4 a0 = *(const f32x4*)(xr + c0) + acc[ai][bj][m][0], a1 = *(const f32x4*)(xr + c0 + 4) + acc[ai][bj][m][1];
                    if (row >= MP) { *(f32x4*)(h1 + (size_t)row * D + c0) = a0; *(f32x4*)(h1 + (size_t)row * D + c0 + 4) = a1; }
                    else { u32x4 wh; wh.x = pk2(a0.x, a0.y); wh.y = pk2(a0.z, a0.w); wh.z = pk2(a1.x, a1.y); wh.w = pk2(a1.z, a1.w); *(u32x4*)(H1 + (size_t)row * D + c0) = wh; }
                    const f32x4 g0 = *(const f32x4*)(gm + c0), g1 = *(const f32x4*)(gm + c0 + 4);
                    u32x4 w; w.x = pk2(a0.x * g0.x, a0.y * g0.y); w.y = pk2(a0.z * g0.z, a0.w * g0.w); w.z = pk2(a1.x * g1.x, a1.y * g1.y); w.w = pk2(a1.z * g1.z, a1.w * g1.w);
                    *(u32x4*)(HG + (size_t)row * D + c0) = w;
                    ss += (a0.x * a0.x + a0.y * a0.y) + (a0.z * a0.z + a0.w * a0.w) + (a1.x * a1.x + a1.y * a1.y) + (a1.z * a1.z + a1.w * a1.w);
                }
                ss += __shfl_xor(ss, 16); ss += __shfl_xor(ss, 32);
                if (fq == 0) atomicAdd(ssq + row, ss);
            }
    }
};
struct EpiUp {
    static constexpr bool PERM = true, AFTER_DRAIN = false;
    const float* ssq; bf16_t* H;
    __device__ __forceinline__ void operator()(const f32x4 (&acc)[2][2][4][2], const Unit& u, int wr, int wc, int fr, int fq) const {
#pragma unroll
        for (int ai = 0; ai < 2; ++ai)
#pragma unroll
            for (int m = 0; m < 4; ++m) {
                const int row = u.pm * 256 + ai * 128 + wr * 64 + m * 16 + fr;
                const float rstd = 1.0f / sqrtf(ssq[row] * (1.0f / 1024.0f) + EPS);
#pragma unroll
                for (int bj = 0; bj < 2; ++bj) {
                    const int c0 = u.pn * 256 + bj * 128 + wc * 32 + 8 * fq;
                    f32x4 a0 = acc[ai][bj][m][0] * rstd, a1 = acc[ai][bj][m][1] * rstd;
                    a0.x = fmaxf(a0.x, 0.f); a0.y = fmaxf(a0.y, 0.f); a0.z = fmaxf(a0.z, 0.f); a0.w = fmaxf(a0.w, 0.f);
                    a1.x = fmaxf(a1.x, 0.f); a1.y = fmaxf(a1.y, 0.f); a1.z = fmaxf(a1.z, 0.f); a1.w = fmaxf(a1.w, 0.f);
                    a0 = a0 * a0; a1 = a1 * a1;
                    u32x4 w; w.x = pk2(a0.x, a0.y); w.y = pk2(a0.z, a0.w); w.z = pk2(a1.x, a1.y); w.w = pk2(a1.z, a1.w);
                    *(u32x4*)(H + (size_t)row * FF + c0) = w;
                }
            }
    }
};
struct EpiDown {
    static constexpr bool PERM = true, AFTER_DRAIN = false;
    const bf16_t* H1; bf16_t* H2;
    __device__ __forceinline__ void operator()(const f32x4 (&acc)[2][2][4][2], const Unit& u, int wr, int wc, int fr, int fq) const {
#pragma unroll
        for (int ai = 0; ai < 2; ++ai)
#pragma unroll
            for (int m = 0; m < 4; ++m) {
                const int row = u.pm * 256 + ai * 128 + wr * 64 + m * 16 + fr;
#pragma unroll
                for (int bj = 0; bj < 2; ++bj) {
                    const int c0 = u.pn * 256 + bj * 128 + wc * 32 + 8 * fq;
                    const u32x4 hq = *(const u32x4*)(H1 + (size_t)row * D + c0);
                    const f32x4 a0 = (f32x4){bflo(hq.x), bfhi(hq.x), bflo(hq.y), bfhi(hq.y)} + acc[ai][bj][m][0], a1 = (f32x4){bflo(hq.z), bfhi(hq.z), bflo(hq.w), bfhi(hq.w)} + acc[ai][bj][m][1];
                    u32x4 w; w.x = pk2(a0.x, a0.y); w.y = pk2(a0.z, a0.w); w.z = pk2(a1.x, a1.y); w.w = pk2(a1.z, a1.w);
                    *(u32x4*)(H2 + (size_t)row * D + c0) = w;
                }
            }
    }
};
struct EpiDownAtomic {
    static constexpr bool PERM = true, AFTER_DRAIN = false;
    float* part;
    __device__ __forceinline__ void operator()(const f32x4 (&acc)[2][2][4][2], const Unit& u, int wr, int wc, int fr, int fq) const {
        float* pb = part + (size_t)(u.k0 >> 10) * MS * D;
#pragma unroll
        for (int ai = 0; ai < 2; ++ai)
#pragma unroll
            for (int m = 0; m < 4; ++m) {
                const int row = u.pm * 256 + ai * 128 + wr * 64 + m * 16 + fr;
#pragma unroll
                for (int bj = 0; bj < 2; ++bj) {
                    const int c0 = u.pn * 256 + bj * 128 + wc * 32 + 8 * fq;
                    float* hp = pb + (size_t)row * D + c0;
                    *(f32x4*)hp = acc[ai][bj][m][0]; *(f32x4*)(hp + 4) = acc[ai][bj][m][1];
                }
            }
    }
};
struct SplitOrder {
    int G, c;
    __device__ bool next(int i, Unit& u) const { const int L = i * G + c; if (L >= 64) return false; const int kp = L >> 4, t = L & 15; u.pm = t >> 2; u.pn = t & 3; u.k0 = kp * 1024; return true; }
    __device__ __forceinline__ void a_ready(const Unit&) const {}
    __device__ __forceinline__ void done(const Unit&) const {}
};

constexpr int PB = 136;
__device__ __forceinline__ void ssd_prompt_unit(const Params& p, LAS unsigned char* lds, int b, int h) {
    const int tid = threadIdx.x, lane = tid & 63, w = __builtin_amdgcn_readfirstlane(tid >> 6), r32 = lane & 31, hh = lane >> 5;
    const int g = h >> 2;
    const bf16_t* U = (const bf16_t*)(p.ws + WS_U); const float* DT = (const float*)(p.ws + WS_DT); bf16_t* Y = (bf16_t*)(p.ws + WS_Y);
    LAS bf16_t* sB = (LAS bf16_t*)lds;
    LAS bf16_t* sC = sB + 128 * PB;
    LAS bf16_t* sXT = sC + 128 * PB;
    LAS bf16_t* sXW = sXT + 64 * PB;
    LAS bf16_t* sH = sXW + 64 * PB;
    LAS float* sA = (LAS float*)(sH + 64 * PB);
    LAS float* sDt = sA + 128;
    const float Ah = -__expf(p.a_log[h]), dtb = p.dt_bias[h], Dsk = p.d_skip[h];
    __syncthreads();
    for (int i = tid; i < 64 * PB / 2; i += 512) ((LAS unsigned*)sH)[i] = 0u;
    const int oct = tid % 40, tl = tid / 40;
    int ucol; if (oct < 8) ucol = 1536 + h * 64 + 8 * oct; else if (oct < 24) ucol = 2048 + g * 128 + 8 * (oct - 8); else ucol = 2304 + g * 128 + 8 * (oct - 24);
    LAS float* sCW = sDt + 128;
    for (int i = tid; i < 1600; i += 512) { const int oc = i / 40, k = i % 40;
        const int ch = (oc < 8) ? (h * 64 + 8 * oc) : (oc < 24) ? (512 + g * 128 + 8 * (oc - 8)) : (768 + g * 128 + 8 * (oc - 24));
        sCW[i] = (k < 32) ? p.conv_w[(k >> 3) * 1024 + ch + (k & 7)] : p.conv_b[ch + k - 32]; }
    __syncthreads();
    f32x16 hacc;
#pragma unroll
    for (int r = 0; r < 16; ++r) hacc[r] = 0.f;
    const int bi = w >> 1, pt = w & 1, nt = w >> 1;
    const int tb = tl * 11;
    u32x4 pw1, pw2, pw3, nx[4];
    pw1 = pw2 = pw3 = (u32x4){0u, 0u, 0u, 0u};
#pragma unroll
    for (int k = 0; k < 4; ++k) nx[k] = (u32x4){0u, 0u, 0u, 0u};
    if (tid < 480) {
        const bf16_t* upn = U + ((size_t)b * SEQ + tb) * NU + ucol;
        if (tb >= 3) { pw1 = *(const u32x4*)(upn - 3 * (ptrdiff_t)NU); pw2 = *(const u32x4*)(upn - 2 * (ptrdiff_t)NU); pw3 = *(const u32x4*)(upn - (ptrdiff_t)NU); }
#pragma unroll
        for (int k = 0; k < 4; ++k) if (tb + k < 128) nx[k] = *(const u32x4*)(upn + (size_t)k * NU);
    }
    float dtn = 0.f, dtn0 = 0.f;
    if (w < 2) { dtn = DT[((size_t)b * SEQ + 64 * w + lane) * 8 + h]; dtn0 = DT[((size_t)b * SEQ + lane) * 8 + h]; }
    for (int c = 0; c < 16; ++c) {
        const int t0 = c * 128; const size_t rowb = (size_t)b * SEQ + t0;
        if (w < 2) {
            const int t = 64 * w + lane;
            const float dtv = softplus(dtn + dtb);
            float sc = dtv * Ah;
#pragma unroll
            for (int o = 1; o < 64; o <<= 1) { const float n = __shfl_up(sc, o); if (lane >= o) sc += n; }
            if (w == 1) { const float d0 = softplus(dtn0 + dtb); sc += wave_sum(d0 * Ah); }
            sA[t] = sc; sDt[t] = dtv;
            if (c < 15) { dtn = DT[(rowb + 128 + t) * 8 + h]; dtn0 = DT[(rowb + 128 + lane) * 8 + h]; }
        }
        if (HY_T1 && tid < 480) {
            float cw[4][8], cb[8];
#pragma unroll
            for (int tp = 0; tp < 4; ++tp) { const f32x4 a = *(const LAS f32x4*)(sCW + oct * 40 + tp * 8), cc = *(const LAS f32x4*)(sCW + oct * 40 + tp * 8 + 4);
                cw[tp][0] = a.x; cw[tp][1] = a.y; cw[tp][2] = a.z; cw[tp][3] = a.w; cw[tp][4] = cc.x; cw[tp][5] = cc.y; cw[tp][6] = cc.z; cw[tp][7] = cc.w; }
            { const f32x4 a = *(const LAS f32x4*)(sCW + oct * 40 + 32), cc = *(const LAS f32x4*)(sCW + oct * 40 + 36);
              cb[0] = a.x; cb[1] = a.y; cb[2] = a.z; cb[3] = a.w; cb[4] = cc.x; cb[5] = cc.y; cb[6] = cc.z; cb[7] = cc.w; }
            u32x4 win[4];
            const bf16_t* up = U + ((size_t)b * SEQ + t0 + tb) * NU + ucol;
            win[1] = pw1; win[2] = pw2; win[3] = pw3;
#pragma unroll 1
            for (int i = 0; i < 11; ++i) {
                const int t = tb + i; if (t >= 128) break;
                win[0] = win[1]; win[1] = win[2]; win[2] = win[3]; win[3] = nx[0];
                nx[0] = nx[1]; nx[1] = nx[2]; nx[2] = nx[3];
                if (t + 4 < 128 && i + 4 < 11) nx[3] = *(const u32x4*)(up + (size_t)(i + 4) * NU);
                float o[8];
#pragma unroll
                for (int e = 0; e < 8; ++e) o[e] = cb[e];
#pragma unroll
                for (int tp = 0; tp < 4; ++tp) {
                    const u32x4 q = win[tp];
                    o[0] += cw[tp][0] * bflo(q.x); o[1] += cw[tp][1] * bfhi(q.x); o[2] += cw[tp][2] * bflo(q.y); o[3] += cw[tp][3] * bfhi(q.y);
                    o[4] += cw[tp][4] * bflo(q.z); o[5] += cw[tp][5] * bfhi(q.z); o[6] += cw[tp][6] * bflo(q.w); o[7] += cw[tp][7] * bfhi(q.w);
                }
#pragma unroll
                for (int e = 0; e < 8; ++e) o[e] = silu(o[e]);
                if (oct < 8) {
#pragma unroll
                    for (int e = 0; e < 8; ++e) sXT[(8 * oct + e) * PB + t] = (bf16_t)f2bf(o[e]);
                } else {
                    u32x4 wv; wv.x = pk2(o[0], o[1]); wv.y = pk2(o[2], o[3]); wv.z = pk2(o[4], o[5]); wv.w = pk2(o[6], o[7]);
                    LAS bf16_t* dst = (oct < 24) ? (sB + t * PB + 8 * (oct - 8)) : (sC + t * PB + 8 * (oct - 24));
                    *(LAS u32x4*)dst = wv;
                }
            }
        }
        __syncthreads();
        { const float aL = sA[127];
#pragma unroll
          for (int k = 0; k < 2; ++k) { const int idx = tid + 512 * k, pp = idx >> 4, to = (idx & 15) * 8;
              const u32x4 q = *(const LAS u32x4*)(sXT + pp * PB + to);
              float wgt[8];
#pragma unroll
              for (int e = 0; e < 8; ++e) wgt[e] = __expf(aL - sA[to + e]) * sDt[to + e];
              u32x4 o; o.x = pk2(bflo(q.x) * wgt[0], bfhi(q.x) * wgt[1]); o.y = pk2(bflo(q.y) * wgt[2], bfhi(q.y) * wgt[3]);
              o.z = pk2(bflo(q.z) * wgt[4], bfhi(q.z) * wgt[5]); o.w = pk2(bflo(q.w) * wgt[6], bfhi(q.w) * wgt[7]);
              *(LAS u32x4*)(sXW + pp * PB + to) = o; } }
        __syncthreads();
        if (tid < 480 && c < 15) {
            const bf16_t* upn = U + ((size_t)b * SEQ + t0 + 128 + tb) * NU + ucol;
            pw1 = *(const u32x4*)(upn - 3 * (ptrdiff_t)NU); pw2 = *(const u32x4*)(upn - 2 * (ptrdiff_t)NU); pw3 = *(const u32x4*)(upn - (ptrdiff_t)NU);
#pragma unroll
            for (int k = 0; k < 4; ++k) if (tb + k < 128) nx[k] = *(const u32x4*)(upn + (size_t)k * NU);
        }
        if (HY_T2) {
            f32x16 yd, yo;
#pragma unroll
            for (int r = 0; r < 16; ++r) { yd[r] = 0.f; yo[r] = 0.f; }
            const int icol = 32 * bi + r32; const float a_i = sA[icol];
            for (int bj = 0; bj <= bi; ++bj) {
                f32x16 X;
#pragma unroll
                for (int r = 0; r < 16; ++r) X[r] = 0.f;
#pragma unroll 4
                for (int s = 0; s < 8; ++s) {
                    const bf16x8 Af = *(const LAS bf16x8*)(sB + (32 * bj + r32) * PB + 16 * s + 8 * hh);
                    const bf16x8 Bf = *(const LAS bf16x8*)(sC + icol * PB + 16 * s + 8 * hh);
                    X = MFMA32(Af, Bf, X);
                }
#pragma unroll
                for (int r = 0; r < 16; ++r) { const int j = 32 * bj + crow(r, hh); const float f = __expf(a_i - sA[j]) * sDt[j]; X[r] = (j <= icol) ? X[r] * f : 0.f; }
#pragma unroll
                for (int s = 0; s < 2; ++s) {
                    const LAS bf16_t* xp_ = sXT + (32 * pt + r32) * PB + 32 * bj + 16 * s + 4 * hh;
                    const bf16x8 Af = ld2x8(xp_, xp_ + 8);
                    yd = MFMA32(Af, pack8(X, s), yd);
                }
            }
            u32x2 zz4[4];
#pragma unroll
            for (int q4 = 0; q4 < 4; ++q4) zz4[q4] = *(const u32x2*)(U + (rowb + icol) * NU + 1024 + h * 64 + 32 * pt + 8 * q4 + 4 * hh);
#pragma unroll 4
            for (int s = 0; s < 8; ++s) {
                const bf16x8 Af = *(const LAS bf16x8*)(sH + (32 * pt + r32) * PB + 16 * s + 8 * hh);
                const bf16x8 Bf = *(const LAS bf16x8*)(sC + icol * PB + 16 * s + 8 * hh);
                yo = MFMA32(Af, Bf, yo);
            }
            const float ea = __expf(a_i);
            const size_t row = rowb + icol;
#pragma unroll
            for (int q4 = 0; q4 < 4; ++q4) {
                const int p0 = 32 * pt + 8 * q4 + 4 * hh;
                const u32x2 zz = zz4[q4];
                float yv[4];
#pragma unroll
                for (int e = 0; e < 4; ++e) { const float xv = bf2f(sXT[(p0 + e) * PB + icol]); yv[e] = yd[4 * q4 + e] + ea * yo[4 * q4 + e] + Dsk * xv; }
                yv[0] *= silu(bflo(zz.x)); yv[1] *= silu(bfhi(zz.x)); yv[2] *= silu(bflo(zz.y)); yv[3] *= silu(bfhi(zz.y));
                u32x2 o; o.x = pk2(yv[0], yv[1]); o.y = pk2(yv[2], yv[3]);
                *(u32x2*)(Y + row * 512 + h * 64 + p0) = o;
            }
        }
        if (HY_T3) {
            const float dec = __expf(sA[127]);
#pragma unroll
            for (int r = 0; r < 16; ++r) hacc[r] *= dec;
#pragma unroll 2
            for (int s = 0; s < 8; ++s) {
                const bf16x8 Af = *(const LAS bf16x8*)(sXW + (32 * pt + r32) * PB + 16 * s + 8 * hh);
                const LAS bf16_t* bp = sB + (16 * s + 8 * hh) * PB + 32 * nt + r32;
                u32x4 wv; wv.x = (unsigned)bp[0] | ((unsigned)bp[PB] << 16); wv.y = (unsigned)bp[2 * PB] | ((unsigned)bp[3 * PB] << 16);
                wv.z = (unsigned)bp[4 * PB] | ((unsigned)bp[5 * PB] << 16); wv.w = (unsigned)bp[6 * PB] | ((unsigned)bp[7 * PB] << 16);
                hacc = MFMA32(Af, __builtin_bit_cast(bf16x8, wv), hacc);
            }
        }
        __syncthreads();
#pragma unroll
        for (int r = 0; r < 16; ++r) sH[(32 * pt + crow(r, hh)) * PB + 32 * nt + r32] = (bf16_t)f2bf(hacc[r]);
    }
    float* so = p.out + O_SP + (size_t)(b * 8 + h) * 64 * 128;
#pragma unroll
    for (int r = 0; r < 16; ++r) so[(32 * pt + crow(r, hh)) * 128 + 32 * nt + r32] = hacc[r];
}

constexpr int VP = 264, KP = 72;
__device__ __forceinline__ void attn_prompt_unit(const Params& p, LAS unsigned char* lds, int unit) {
    const int tid = threadIdx.x, lane = tid & 63, w = __builtin_amdgcn_readfirstlane(tid >> 6), r32 = lane & 31, hh = lane >> 5;
    const int g = unit >> 10, rr = unit & 1023, b = rr >> 6, r2 = rr & 63, kvh = r2 >> 4, zn = r2 & 15;
    const int dsh = 2 * g, d = 1 << dsh;
    const int nbl = 16 >> dsh;
    const int z = zn / nbl, n = zn % nbl;
    const bf16_t* U = (const bf16_t*)(p.ws + WS_U);
    bf16_t* PO = (bf16_t*)(p.ws + WS_PO) + (size_t)g * M * 512; float* LSE = (float*)(p.ws + WS_LSE) + (size_t)g * M * 8;
    LAS bf16_t* sK = (LAS bf16_t*)lds;
    LAS bf16_t* sVT = sK + 256 * KP;
    const size_t rowb = (size_t)b * SEQ;
    const int sub0 = 128 * (n - 1);
    __syncthreads();
#pragma unroll
    for (int k = 0; k < 4; ++k) {
        const int idx = tid + 512 * k, key = idx >> 3, oc = idx & 7;
        const int js = sub0 + key;
        u32x4 q = (u32x4){0u, 0u, 0u, 0u}, kq = q;
        if (js >= 0) { const bf16_t* rp = U + (rowb + z + (size_t)d * js) * NU + kvh * 64 + 8 * oc; kq = *(const u32x4*)(rp + 512); q = *(const u32x4*)(rp + 768); }
        *(LAS u32x4*)(sK + key * KP + 8 * oc) = kq;
        LAS bf16_t* dst = sVT + (8 * oc) * VP + (key ^ (oc << 2));
        dst[0] = (bf16_t)(q.x & 0xffffu); dst[VP] = (bf16_t)(q.x >> 16); dst[2 * VP] = (bf16_t)(q.y & 0xffffu); dst[3 * VP] = (bf16_t)(q.y >> 16);
        dst[4 * VP] = (bf16_t)(q.z & 0xffffu); dst[5 * VP] = (bf16_t)(q.z >> 16); dst[6 * VP] = (bf16_t)(q.w & 0xffffu); dst[7 * VP] = (bf16_t)(q.w >> 16);
    }
    const int w3 = w & 3, hq = kvh * 2 + (w >> 2);
    const int qsub = 128 * n + 32 * w3 + r32;
    const size_t qrow = rowb + z + (size_t)d * qsub;
    bf16x8 qf[4];
#pragma unroll
    for (int s = 0; s < 4; ++s) qf[s] = *(const bf16x8*)(U + qrow * NU + hq * 64 + 16 * s + 8 * hh);
    __syncthreads();
    f32x16 S[5];
    const int iq = 128 + 32 * w3 + r32;
#pragma unroll
    for (int kk = 0; kk < 5; ++kk) {
        const int kb = w3 + kk;
        const bool live = (n > 0) || (kb >= 4);
#pragma unroll
        for (int r = 0; r < 16; ++r) S[kk][r] = 0.f;
        if (live) {
            const LAS bf16_t* kp = sK + (32 * kb + r32) * KP + 8 * hh;
#pragma unroll
            for (int s = 0; s < 4; ++s) { const bf16x8 kf = *(const LAS bf16x8*)(kp + 16 * s); S[kk] = MFMA32(kf, qf[s], S[kk]); }
        }
#pragma unroll
        for (int r = 0; r < 16; ++r) { const int jb = 32 * kb + crow(r, hh); const int dist = iq - jb; const bool ok = live && dist >= 0 && dist <= 128; S[kk][r] = ok ? S[kk][r] : -1e30f; }
    }
    float mx = -1e30f;
#pragma unroll
    for (int kk = 0; kk < 5; ++kk)
#pragma unroll
        for (int r = 0; r < 16; ++r) mx = fmaxf(mx, S[kk][r]);
    mx = fmaxf(mx, __shfl_xor(mx, 32));
    float l = 0.f;
#pragma unroll
    for (int kk = 0; kk < 5; ++kk)
#pragma unroll
        for (int r = 0; r < 16; ++r) { const float e = __expf(S[kk][r] - mx); S[kk][r] = e; l += e; }
    l += __shfl_xor(l, 32);
    f32x16 O0, O1;
#pragma unroll
    for (int r = 0; r < 16; ++r) { O0[r] = 0.f; O1[r] = 0.f; }
#pragma unroll
    for (int kk = 0; kk < 5; ++kk) {
        const int kb = w3 + kk;
#pragma unroll
        for (int s = 0; s < 2; ++s) {
            const bf16x8 pf = pack8(S[kk], s);
            const int k0 = 32 * kb + 16 * s + 4 * hh, sw0 = (r32 >> 3) << 2, sw1 = sw0 + 16;
            const LAS bf16_t* v0 = sVT + r32 * VP;
            const LAS bf16_t* v1 = v0 + 32 * VP;
            O0 = MFMA32(ld2x8(v0 + (k0 ^ sw0), v0 + ((k0 + 8) ^ sw0)), pf, O0);
            O1 = MFMA32(ld2x8(v1 + (k0 ^ sw1), v1 + ((k0 + 8) ^ sw1)), pf, O1);
        }
    }
    const float il = 1.0f / l;
    bf16_t* po = PO + qrow * 512 + hq * 64;
#pragma unroll
    for (int q4 = 0; q4 < 4; ++q4) {
        const int d0 = 8 * q4 + 4 * hh;
        u32x2 o; o.x = pk2(O0[4 * q4] * il, O0[4 * q4 + 1] * il); o.y = pk2(O0[4 * q4 + 2] * il, O0[4 * q4 + 3] * il);
        *(u32x2*)(po + d0) = o;
        o.x = pk2(O1[4 * q4] * il, O1[4 * q4 + 1] * il); o.y = pk2(O1[4 * q4 + 2] * il, O1[4 * q4 + 3] * il);
        *(u32x2*)(po + 32 + d0) = o;
    }
    if (hh == 0) LSE[qrow * 8 + hq] = mx + __logf(l);
}

__device__ __forceinline__ void attn_sample_item(const Params& p, LAS unsigned char* lds, int item) {
    const int tid = threadIdx.x, lane = tid & 63, t = __builtin_amdgcn_readfirstlane(tid >> 6);
    const int g = item % 3, r = item / 3, kvh = r & 3, b = r >> 2;
    const int d = 1 << (2 * g);
    const int sub = lane >> 4, dl = lane & 15;
    const bf16_t* U = (const bf16_t*)(p.ws + WS_U);
    const size_t row = (size_t)MP + b * 8 + t;
    float q0[4], q1[4];
    { const u32x2 a = *(const u32x2*)(U + row * NU + (kvh * 2) * 64 + 4 * dl), c = *(const u32x2*)(U + row * NU + (kvh * 2 + 1) * 64 + 4 * dl);
      q0[0] = bflo(a.x); q0[1] = bfhi(a.x); q0[2] = bflo(a.y); q0[3] = bfhi(a.y); q1[0] = bflo(c.x); q1[1] = bfhi(c.x); q1[2] = bflo(c.y); q1[3] = bfhi(c.y); }
    const float* ck = p.cache_k + (size_t)b * WC * 256 + kvh * 64 + 4 * dl;
    const float* cv = p.cache_v + (size_t)b * WC * 256 + kvh * 64 + 4 * dl;
    const float* nk = p.out + O_KS + (size_t)b * WC * 256 + kvh * 64 + 4 * dl;
    const float* nv = p.out + O_VS + (size_t)b * WC * 256 + kvh * 64 + 4 * dl;
    float m0 = -1e30f, m1 = -1e30f, l0 = 0.f, l1 = 0.f; f32x4 o0 = (f32x4){0.f, 0.f, 0.f, 0.f}, o1 = o0;
#pragma unroll 1
    for (int bt = 0; bt < 3; ++bt) {
        f32x4 kv[11], vv[11];
#pragma unroll
        for (int u = 0; u < 11; ++u) { const int j = 4 * (bt * 11 + u) + sub, jc = j < 128 ? j : 128; const int idx = WC + t - d * jc;
            const size_t off = (idx < WC) ? (size_t)idx * 256 : (size_t)(idx - 8) * 256;
            kv[u] = *(const f32x4*)(((idx < WC) ? ck : nk) + off); vv[u] = *(const f32x4*)(((idx < WC) ? cv : nv) + off); }
        float a0[11], a1[11]; float bm0 = -1e30f, bm1 = -1e30f;
#pragma unroll
        for (int u = 0; u < 11; ++u) {
            const int j = 4 * (bt * 11 + u) + sub;
            float x0 = q0[0] * kv[u].x + q0[1] * kv[u].y + q0[2] * kv[u].z + q0[3] * kv[u].w;
            float x1 = q1[0] * kv[u].x + q1[1] * kv[u].y + q1[2] * kv[u].z + q1[3] * kv[u].w;
#pragma unroll
            for (int o = 1; o < 16; o <<= 1) { x0 += __shfl_xor(x0, o); x1 += __shfl_xor(x1, o); }
            if (j > 128) { x0 = -1e30f; x1 = -1e30f; }
            a0[u] = x0; a1[u] = x1; bm0 = fmaxf(bm0, x0); bm1 = fmaxf(bm1, x1);
        }
        bm0 = fmaxf(bm0, __shfl_xor(bm0, 16)); bm0 = fmaxf(bm0, __shfl_xor(bm0, 32)); bm1 = fmaxf(bm1, __shfl_xor(bm1, 16)); bm1 = fmaxf(bm1, __shfl_xor(bm1, 32));
        const float mn0 = fmaxf(m0, bm0), mn1 = fmaxf(m1, bm1); const float sc0 = __expf(m0 - mn0), sc1 = __expf(m1 - mn1);
        l0 *= sc0; l1 *= sc1; o0 = o0 * sc0; o1 = o1 * sc1; m0 = mn0; m1 = mn1;
#pragma unroll
        for (int u = 0; u < 11; ++u) {
            const int j = 4 * (bt * 11 + u) + sub;
            const float e0 = (j <= 128) ? __expf(a0[u] - m0) : 0.f, e1 = (j <= 128) ? __expf(a1[u] - m1) : 0.f;
            l0 += e0; l1 += e1; o0 += vv[u] * e0; o1 += vv[u] * e1;
        }
    }
#pragma unroll
    for (int o = 16; o < 64; o <<= 1) { l0 += __shfl_xor(l0, o); l1 += __shfl_xor(l1, o);
        o0.x += __shfl_xor(o0.x, o); o0.y += __shfl_xor(o0.y, o); o0.z += __shfl_xor(o0.z, o); o0.w += __shfl_xor(o0.w, o);
        o1.x += __shfl_xor(o1.x, o); o1.y += __shfl_xor(o1.y, o); o1.z += __shfl_xor(o1.z, o); o1.w += __shfl_xor(o1.w, o); }
    if (sub == 0) {
        bf16_t* PO = (bf16_t*)(p.ws + WS_PO) + (size_t)g * M * 512; float* LSE = (float*)(p.ws + WS_LSE) + (size_t)g * M * 8;
        const float i0 = 1.0f / l0, i1 = 1.0f / l1;
        u32x2 o; o.x = pk2(o0.x * i0, o0.y * i0); o.y = pk2(o0.z * i0, o0.w * i0); *(u32x2*)(PO + row * 512 + (kvh * 2) * 64 + 4 * dl) = o;
        o.x = pk2(o1.x * i1, o1.y * i1); o.y = pk2(o1.z * i1, o1.w * i1); *(u32x2*)(PO + row * 512 + (kvh * 2 + 1) * 64 + 4 * dl) = o;
        if (dl == 0) { LSE[row * 8 + kvh * 2] = m0 + __logf(l0); LSE[row * 8 + kvh * 2 + 1] = m1 + __logf(l1); }
    }
}

__device__ __forceinline__ void ssd_sample_item(const Params& p, LAS unsigned char* lds, int item) {
    const int tid = threadIdx.x, b = item >> 3, h = item & 7, g = h >> 2;
    const bf16_t* U = (const bf16_t*)(p.ws + WS_U); const float* DT = (const float*)(p.ws + WS_DT); bf16_t* Y = (bf16_t*)(p.ws + WS_Y);
    LAS float* sx = (LAS float*)lds;
    LAS float* sBn = sx + 512;
    LAS float* sCn = sBn + 1024;
    __syncthreads();
    for (int i = tid; i < 8 * 320; i += 512) {
        const int t = i / 320, c = i % 320;
        int ucol; if (c < 64) ucol = 1536 + h * 64 + c; else if (c < 192) ucol = 2048 + g * 128 + (c - 64); else ucol = 2304 + g * 128 + (c - 192);
        const int ch = ucol - 1536;
        float o = p.conv_b[ch];
#pragma unroll
        for (int tp = 0; tp < 4; ++tp) { const int r = t + tp;
            const float v = (r < 3) ? p.state_conv[((size_t)b * 3 + r) * 1024 + ch] : bf2f(U[((size_t)MP + b * 8 + (r - 3)) * NU + ucol]);
            o += p.conv_w[tp * 1024 + ch] * v; }
        o = silu(o);
        if (c < 64) sx[t * 64 + c] = o; else if (c < 192) sBn[t * 128 + c - 64] = o; else sCn[t * 128 + c - 192] = o;
    }
    __syncthreads();
    const int pp = tid >> 3, n0 = (tid & 7) * 16;
    const float Ah = -__expf(p.a_log[h]), dtb = p.dt_bias[h], Dsk = p.d_skip[h];
    const float* s0 = p.state_ssm + ((size_t)(b * 8 + h) * 64 + pp) * 128 + n0;
    float st[16];
#pragma unroll
    for (int k = 0; k < 4; ++k) { const f32x4 v = *(const f32x4*)(s0 + 4 * k); st[4 * k] = v.x; st[4 * k + 1] = v.y; st[4 * k + 2] = v.z; st[4 * k + 3] = v.w; }
    float dts[8], zs[8];
#pragma unroll
    for (int t = 0; t < 8; ++t) { const size_t row = (size_t)MP + b * 8 + t; dts[t] = DT[row * 8 + h]; zs[t] = bf2f(U[row * NU + 1024 + h * 64 + pp]); }
#pragma unroll
    for (int t = 0; t < 8; ++t) {
        const size_t row = (size_t)MP + b * 8 + t;
        const float dtv = softplus(dts[t] + dtb), dA = __expf(dtv * Ah);
        const float xv = sx[t * 64 + pp], xdt = xv * dtv;
        float y = 0.f;
#pragma unroll
        for (int k = 0; k < 16; ++k) { st[k] = st[k] * dA + xdt * sBn[t * 128 + n0 + k]; y += sCn[t * 128 + n0 + k] * st[k]; }
        y += __shfl_xor(y, 1); y += __shfl_xor(y, 2); y += __shfl_xor(y, 4);
        if ((tid & 7) == 0) {
            const float zv = zs[t];
            Y[row * 512 + h * 64 + pp] = (bf16_t)f2bf((y + Dsk * xv) * silu(zv));
        }
    }
    float* so = p.out + O_SS + ((size_t)(b * 8 + h) * 64 + pp) * 128 + n0;
#pragma unroll
    for (int k = 0; k < 4; ++k) *(f32x4*)(so + 4 * k) = (f32x4){st[4 * k], st[4 * k + 1], st[4 * k + 2], st[4 * k + 3]};
}


__device__ __forceinline__ void copy_item(const Params& p, int item) {
    const int tid = threadIdx.x, pr = item >> 2, part = item & 3, tns = pr >> 7, b = pr & 127;
    const f32x4* src = (const f32x4*)((tns ? p.cache_v : p.cache_k) + (size_t)b * WC * 256 + 8 * 256) + part * 32640 + tid;
    f32x4* dst = (f32x4*)(p.out + (tns ? O_VS : O_KS) + (size_t)b * WC * 256) + part * 32640 + tid;
    constexpr int NI = 32640;
    f32x4 va[8], vb[8];
#pragma unroll
    for (int u = 0; u < 8; ++u) { const int i = 512 * u; if (i + tid < NI) va[u] = __builtin_nontemporal_load(src + i); }
#pragma unroll 1
    for (int r = 0; r < 8; r += 2) {
#pragma unroll
        for (int u = 0; u < 8; ++u) { const int i = (r + 1) * 4096 + 512 * u; if (i + tid < NI) vb[u] = __builtin_nontemporal_load(src + i); }
#pragma unroll
        for (int u = 0; u < 8; ++u) { const int i = r * 4096 + 512 * u; if (i + tid < NI) __builtin_nontemporal_store(va[u], dst + i); }
#pragma unroll
        for (int u = 0; u < 8; ++u) { const int i = (r + 2) * 4096 + 512 * u; if (r + 2 < 8 && i + tid < NI) va[u] = __builtin_nontemporal_load(src + i); }
#pragma unroll
        for (int u = 0; u < 8; ++u) { const int i = (r + 1) * 4096 + 512 * u; if (i + tid < NI) __builtin_nontemporal_store(vb[u], dst + i); }
    }
}
constexpr int N_COPY = 1024;
#ifndef HY_CQ1
#define HY_CQ1 0
#define HY_CQ3 0
#define HY_CQ4 0
#define HY_CQ5 0
#endif
constexpr int N_COPY_P2 = N_COPY;
__device__ __forceinline__ void copy_quota(const Params& p, LAS unsigned char* lds, int quota) {
    unsigned* cctr = (unsigned*)(p.ws + WS_CTL) + 32;
    volatile LAS int* sItem = (volatile LAS int*)(lds + MISC_OFF);
    for (int q = 0; q < quota; ++q) {
        __syncthreads();
        if (threadIdx.x == 0) sItem[0] = (int)atomicAdd(cctr, 1u);
        __syncthreads();
        const int it = sItem[0];
        if (it >= N_COPY) break;
        copy_item(p, it);
    }
}
__device__ __forceinline__ bool short_block(int nwg) { const int G = gridDim.x, c = blockIdx.x; return (nwg - c + G - 1) / G < (nwg + G - 1) / G; }
constexpr int N_SSDP = 128, N_ATTP = 3072, N_SSDS = 1024, N_ATTS = 1536, N_P2 = N_SSDP + N_ATTP + N_SSDS + N_ATTS + N_COPY_P2;
__device__ __forceinline__ void phase2(const Params& p, LAS unsigned char* lds, int cidx, int ilo = 0, int ihi = 1 << 30) {
    unsigned* ctr = (unsigned*)(p.ws + WS_CTL) + cidx;
    volatile LAS int* sItem = (volatile LAS int*)(lds + MISC_OFF);
    if (cidx == 0) {
        const int G = (int)gridDim.x;
        if ((G & 7) == 0 && G >= 128) { const int xcd = (int)blockIdx.x & 7, slot = (int)blockIdx.x >> 3; if (slot < 16) { const int u = xcd * 16 + slot; ssd_prompt_unit(p, lds, u >> 3, u & 7); } }
        else { for (int u = (int)blockIdx.x; u < N_SSDP; u += G) ssd_prompt_unit(p, lds, u >> 3, u & 7); }
    }
    for (;;) {
        __syncthreads();
        if (threadIdx.x == 0) sItem[0] = (int)atomicAdd(ctr, 1u);
        __syncthreads();
        int it = sItem[0] + ilo + (cidx == 0 ? N_SSDP : 0);
        if (it >= N_P2 || it >= ihi) break;
        if (it < N_SSDP) { if (HY_P2MASK & 1) ssd_prompt_unit(p, lds, it >> 3, it & 7); continue; } it -= N_SSDP;
        if (it < 5120) { const int grp = it / 10, pos = it % 10;
          if (pos == 4 || pos == 9) { copy_item(p, 2 * grp + (pos == 9)); continue; }
          it = grp * 8 + (pos < 4 ? pos : pos - 1); }
        else it = 4096 + (it - 5120);
        if (it < N_ATTS) { if (HY_P2MASK & 8) attn_sample_item(p, lds, it); continue; } it -= N_ATTS;
        if (it < N_SSDS) { if (HY_P2MASK & 4) ssd_sample_item(p, lds, it); continue; } it -= N_SSDS;
        if (HY_P2MASK & 2) attn_prompt_unit(p, lds, it);
    }
}

__device__ __forceinline__ void phase2b(const Params& p) {
    const int tid = threadIdx.x, lane = tid & 63, wave = tid >> 6, gw = blockIdx.x * 8 + wave, NGW = gridDim.x * 8;
    const bf16_t* PO = (const bf16_t*)(p.ws + WS_PO); const float* LSE = (const float*)(p.ws + WS_LSE); const bf16_t* Y = (const bf16_t*)(p.ws + WS_Y);
    bf16_t* MIX = (bf16_t*)(p.ws + WS_MIX);
    const f32x4 sn0 = *(const f32x4*)(p.ssm_norm + 8 * lane), sn1 = *(const f32x4*)(p.ssm_norm + 8 * lane + 4);
    const int hd = lane >> 3;
    for (int row0 = gw; row0 < M; row0 += 4 * NGW) {
        u32x4 a[4], c[4], e[4], yq[4]; float l0[4], l1[4], l2[4];
#pragma unroll
        for (int r = 0; r < 4; ++r) { const int row = row0 + r * NGW; if (row < M) {
            l0[r] = LSE[(size_t)row * 8 + hd]; l1[r] = LSE[((size_t)M + row) * 8 + hd]; l2[r] = LSE[((size_t)2 * M + row) * 8 + hd];
            a[r] = *(const u32x4*)(PO + (size_t)row * 512 + 8 * lane); c[r] = *(const u32x4*)(PO + ((size_t)M + row) * 512 + 8 * lane); e[r] = *(const u32x4*)(PO + ((size_t)2 * M + row) * 512 + 8 * lane);
            yq[r] = *(const u32x4*)(Y + (size_t)row * 512 + 8 * lane); } }
#pragma unroll
        for (int r = 0; r < 4; ++r) { const int row = row0 + r * NGW; if (row < M) {
            const float mx = fmaxf(l0[r], fmaxf(l1[r], l2[r])); float w0 = __expf(l0[r] - mx), w1 = __expf(l1[r] - mx), w2 = __expf(l2[r] - mx);
            const float iw = 1.0f / (w0 + w1 + w2); w0 *= iw; w1 *= iw; w2 *= iw;
            u32x4 o;
            o.x = pk2(w0 * bflo(a[r].x) + w1 * bflo(c[r].x) + w2 * bflo(e[r].x), w0 * bfhi(a[r].x) + w1 * bfhi(c[r].x) + w2 * bfhi(e[r].x));
            o.y = pk2(w0 * bflo(a[r].y) + w1 * bflo(c[r].y) + w2 * bflo(e[r].y), w0 * bfhi(a[r].y) + w1 * bfhi(c[r].y) + w2 * bfhi(e[r].y));
            o.z = pk2(w0 * bflo(a[r].z) + w1 * bflo(c[r].z) + w2 * bflo(e[r].z), w0 * bfhi(a[r].z) + w1 * bfhi(c[r].z) + w2 * bfhi(e[r].z));
            o.w = pk2(w0 * bflo(a[r].w) + w1 * bflo(c[r].w) + w2 * bflo(e[r].w), w0 * bfhi(a[r].w) + w1 * bfhi(c[r].w) + w2 * bfhi(e[r].w));
            *(u32x4*)(MIX + (size_t)row * 1024 + 8 * lane) = o;
            const u32x4 q = yq[r];
            float y[8] = {bflo(q.x), bfhi(q.x), bflo(q.y), bfhi(q.y), bflo(q.z), bfhi(q.z), bflo(q.w), bfhi(q.w)};
            float ss = 0.f;
#pragma unroll
            for (int k = 0; k < 8; ++k) ss += y[k] * y[k];
#pragma unroll
            for (int of = 1; of < 32; of <<= 1) ss += __shfl_xor(ss, of);
            const float rstd = 1.0f / sqrtf(ss * (1.0f / 256.0f) + EPS);
            u32x4 oy; oy.x = pk2(y[0] * rstd * sn0.x, y[1] * rstd * sn0.y); oy.y = pk2(y[2] * rstd * sn0.z, y[3] * rstd * sn0.w);
            oy.z = pk2(y[4] * rstd * sn1.x, y[5] * rstd * sn1.y); oy.w = pk2(y[6] * rstd * sn1.z, y[7] * rstd * sn1.w);
            *(u32x4*)(MIX + (size_t)row * 1024 + 512 + 8 * lane) = oy; } }
    }
}

__device__ __forceinline__ void phase6(const Params& p) {
    const int tid = threadIdx.x, lane = tid & 63, wave = tid >> 6, gw = blockIdx.x * 8 + wave, NGW = gridDim.x * 8;
    f32x4 g[4];
#pragma unroll
    for (int j = 0; j < 4; ++j) g[j] = ((const f32x4*)p.norm_final)[lane + 64 * j];
    for (int row0 = gw; row0 < M; row0 += 4 * NGW) {
        f32x4 v[4][4];
#pragma unroll
        for (int r = 0; r < 4; ++r) { const int row = row0 + r * NGW; if (row < M) {
            if (row < MP) {
                const u32x2* h2 = (const u32x2*)((const bf16_t*)(p.ws + WS_MIX) + (size_t)row * D);
#pragma unroll
                for (int j = 0; j < 4; ++j) { const u32x2 q = h2[lane + 64 * j]; v[r][j] = (f32x4){bflo(q.x), bfhi(q.x), bflo(q.y), bfhi(q.y)}; }
            } else {
                const f32x4* hr = (const f32x4*)(p.out + (size_t)row * D);
                const f32x4* pr = (const f32x4*)((const float*)(p.ws + WS_PO) + (size_t)(row - MP) * D);
#pragma unroll
                for (int j = 0; j < 4; ++j) { v[r][j] = hr[lane + 64 * j];
#pragma unroll
                    for (int k = 0; k < 4; ++k) v[r][j] += pr[(size_t)k * MS * D / 4 + lane + 64 * j]; }
            } } }
#pragma unroll
        for (int r = 0; r < 4; ++r) { const int row = row0 + r * NGW; if (row < M) {
            float s = 0.f;
#pragma unroll
            for (int j = 0; j < 4; ++j) s += (v[r][j].x * v[r][j].x + v[r][j].y * v[r][j].y) + (v[r][j].z * v[r][j].z + v[r][j].w * v[r][j].w);
            s = wave_sum(s);
            const float rstd = 1.0f / sqrtf(s * (1.0f / 1024.0f) + EPS);
            f32x4* hr = (f32x4*)(p.out + (size_t)row * D);
#pragma unroll
            for (int j = 0; j < 4; ++j) hr[lane + 64 * j] = v[r][j] * rstd * g[j]; } }
    }
}

#define XB_TMO      128
#define XB_XCNT(j)  (256  + 64 * (j))
#define XB_XSUB(j)  (1280 + 64 * (j))
#define XB_XGEN(j)  (2304 + 64 * (j))
#define XB_TOP      3328
#define XB_TOPGEN   3392
#define XCD_BAR_WORDS 3456
#define XB_SPIN_CAP (1u << 18)

__device__ __forceinline__ unsigned xb_ld(unsigned* p)              { return __hip_atomic_load(p, __ATOMIC_RELAXED, __HIP_MEMORY_SCOPE_AGENT); }
__device__ __forceinline__ unsigned xb_add(unsigned* p, unsigned v) { return __hip_atomic_fetch_add(p, v, __ATOMIC_RELAXED, __HIP_MEMORY_SCOPE_AGENT); }
__device__ __forceinline__ unsigned xb_xcc_id() { return (unsigned)__builtin_amdgcn_s_getreg((3 << 11) | 20) & 0xFu; }
#define XB_SPIN(cond, bar) do { unsigned _sp = 0; while (cond) { __builtin_amdgcn_s_sleep(1); \
    if ((++_sp & 255u) == 0u) { if (xb_ld(&(bar)[XB_TMO])) break; if (_sp > XB_SPIN_CAP) { atomicAdd(&(bar)[XB_TMO], 1u); break; } } } } while (0)

struct XcdBarrier {
    unsigned* bar; unsigned x;
    volatile LAS unsigned* st;
};

__device__ __forceinline__ XcdBarrier xcd_barrier_post(unsigned* bar, volatile LAS unsigned* st) {
    XcdBarrier b; b.bar = bar; b.x = xb_xcc_id(); b.st = st;
    if (threadIdx.x == 0) (void)xb_add(&bar[XB_XCNT(b.x)], 1u);
    return b;
}
__device__ __forceinline__ void xcd_barrier_complete(unsigned* bar, unsigned x, unsigned& nloc, unsigned& nx) {
    const unsigned G = gridDim.x * gridDim.y * gridDim.z;
    unsigned sum, cnt, mine, sp = 0u;
    for (;;) {
        sum = 0u; cnt = 0u; mine = 0u;
#pragma unroll
        for (unsigned j = 0; j < 16; ++j) { const unsigned c = xb_ld(&bar[XB_XCNT(j)]); sum += c; cnt += (c > 0u) ? 1u : 0u; mine = (j == x) ? c : mine; }
        if (sum == G) break;
        __builtin_amdgcn_s_sleep(1);
        if ((++sp & 255u) == 0u) { if (xb_ld(&bar[XB_TMO])) break; if (sp > XB_SPIN_CAP) { atomicAdd(&bar[XB_TMO], 1u); break; } }
    }
    nloc = mine > 0u ? mine : 1u; nx = cnt > 0u ? cnt : 1u;
}

__device__ __forceinline__ void xcd_barrier(const XcdBarrier& b) {
    asm volatile("s_waitcnt vmcnt(0)" ::: "memory");
    __syncthreads();
    if (threadIdx.x == 0) {
        unsigned* bar = b.bar;
        __builtin_amdgcn_s_waitcnt(0);
        unsigned nloc = b.st[0], nx = b.st[1];
        if (nloc == 0u) { xcd_barrier_complete(bar, b.x, nloc, nx); b.st[0] = nloc; b.st[1] = nx; }
        const unsigned old = xb_add(&bar[XB_XSUB(b.x)], 1u);
        const unsigned gen = old / nloc;
        if (old + 1u == (gen + 1u) * nloc) {
            __builtin_amdgcn_fence(__ATOMIC_RELEASE, "agent");
            asm volatile("s_waitcnt vmcnt(0)" ::: "memory");
            const unsigned og = xb_add(&bar[XB_TOP], 1u);
            const unsigned tg = og / nx;
            if (og + 1u == (tg + 1u) * nx) xb_add(&bar[XB_TOPGEN], 1u);
            else XB_SPIN(xb_ld(&bar[XB_TOPGEN]) == tg, bar);
            __builtin_amdgcn_fence(__ATOMIC_ACQUIRE, "agent");
            xb_add(&bar[XB_XGEN(b.x)], 1u);
            asm volatile("s_waitcnt vmcnt(0)" ::: "memory");
        } else {
            XB_SPIN(xb_ld(&bar[XB_XGEN(b.x)]) == gen, bar);
            __builtin_amdgcn_fence(__ATOMIC_ACQUIRE, "agent");
            asm volatile("s_waitcnt vmcnt(0)" ::: "memory");
        }
    }
    __syncthreads();
}


__global__ void __launch_bounds__(512, 2) hymba_fwd(Params p) {
    extern __shared__ __attribute__((aligned(16))) unsigned char lds_raw[];
    LAS unsigned char* lds = (LAS unsigned char*)lds_raw;
    cg::grid_group grid = cg::this_grid();
    unsigned char* ws = p.ws;
    float* ssq1 = (float*)(ws + WS_CTL + 4096); float* ssq2 = ssq1 + M;
    const int lo = p.ph_lo, hi = p.ph_hi;
    volatile LAS unsigned* xst = (volatile LAS unsigned*)(lds + MISC_OFF + 64);
    if (threadIdx.x < 2) xst[threadIdx.x] = 0u;
    __syncthreads();
    XcdBarrier xbar = xcd_barrier_post((unsigned*)(ws + WS_CTL + 524288), xst);
#define IN(k) (((HY_MASK >> (k)) & 1) && lo <= (k) && (k) < hi)
#define SEAM(k) do { if (IN(k) && IN((k) + 1)) { if (lo < 0) grid.sync(); else xcd_barrier(xbar); } } while (0)
    if (IN(0)) { phase0(p, lds); if (HY_DUP == 0) { grid.sync(); phase0(p, lds); } } SEAM(0);
    if (IN(1)) {
        pg8::Gemm gm{(const bf16_t*)(ws + WS_XN), (const bf16_t*)(ws + WS_WIN), M, NU, D, D}; pg8::StaticOrder S; S.init(M, NU, (int)gridDim.x, (int)blockIdx.x);
        EpiIn E{(bf16_t*)(ws + WS_U), p.out, (const float*)(ws + WS_ROPE)};
        pg8::gemm_phase<EpiIn, pg8::StaticOrder, true, true>(lds, gm, S, E);
        if (HY_DUP == 1) { grid.sync(); pg8::gemm_phase<EpiIn, pg8::StaticOrder, true, true>(lds, gm, S, E); }
        if (HY_DUP == 1) { grid.sync(); pg8::gemm_phase<EpiIn, pg8::StaticOrder, true, true>(lds, gm, S, E); }
        if (short_block((M / 256) * (NU / 256))) copy_quota(p, lds, HY_CQ1);
    } SEAM(1);
    if (IN(2)) { phase2(p, lds, 0); if (HY_DUP == 2) { grid.sync(); phase2(p, lds, 16, HY_DLO, HY_DHI); } } SEAM(2);
    if (IN(3)) { phase2b(p); if (HY_DUP == 3) { grid.sync(); phase2b(p); } } SEAM(3);
    if (IN(4)) {
        pg8::Gemm gm{(const bf16_t*)(ws + WS_MIX), (const bf16_t*)(ws + WS_WOUT), M, D, D, D}; pg8::StaticOrder S; S.init(M, D, (int)gridDim.x, (int)blockIdx.x);
        EpiOut E{p.x_prompt, p.x_sample, p.out, (bf16_t*)(ws + WS_XN), p.norm_mlp, ssq1, (bf16_t*)(ws + WS_U)};
        pg8::gemm_phase<EpiOut, pg8::StaticOrder, true, true>(lds, gm, S, E);
        if (short_block((M / 256) * (D / 256))) copy_quota(p, lds, HY_CQ3);
    } SEAM(4);
    if (IN(5)) {
        pg8::Gemm gm{(const bf16_t*)(ws + WS_XN), (const bf16_t*)(ws + WS_WUP), M, FF, D, D}; pg8::StaticOrder S; S.init(M, FF, (int)gridDim.x, (int)blockIdx.x);
        EpiUp E{ssq1, (bf16_t*)(ws + WS_H)};
        pg8::gemm_phase<EpiUp, pg8::StaticOrder, true, true>(lds, gm, S, E);
        if (HY_DUP == 5) { grid.sync(); pg8::gemm_phase<EpiUp, pg8::StaticOrder, true, true>(lds, gm, S, E); }
        if (short_block((M / 256) * (FF / 256))) copy_quota(p, lds, HY_CQ4);
    } SEAM(5);
    if (IN(6)) {
        { pg8::Gemm gm{(const bf16_t*)(ws + WS_H), (const bf16_t*)(ws + WS_WDN), MP, D, FF, FF}; pg8::StaticOrder S; S.init(MP, D, (int)gridDim.x, (int)blockIdx.x);
          EpiDown E{(const bf16_t*)(ws + WS_U), (bf16_t*)(ws + WS_MIX)};
          pg8::gemm_phase<EpiDown, pg8::StaticOrder, true, true>(lds, gm, S, E); }
        { pg8::Gemm gm{(const bf16_t*)(ws + WS_H) + (size_t)MP * FF, (const bf16_t*)(ws + WS_WDN), MS, D, 1024, FF}; SplitOrder S{(int)gridDim.x, (int)blockIdx.x};
          EpiDownAtomic E{(float*)(ws + WS_PO)};
          pg8::gemm_phase<EpiDownAtomic, SplitOrder, true, true>(lds, gm, S, E); }
    } SEAM(6);
    if (IN(7)) { phase6(p); }
    if (HY_DUP == 9) { for (int k = 0; k < 8; ++k) grid.sync(); }
#undef IN
#undef SEAM
}
}

extern "C" void kernel_launch(void* const* d_in, const int* in_sizes, int n_in, void* d_out, int out_size, void* d_ws, size_t ws_size, hipStream_t stream) {
    using namespace hy;
    static int grid = 0;
    if (grid == 0) {
        if (n_in != 19 || (size_t)out_size != O_END || ws_size < WS_END) { fprintf(stderr, "kernel_launch: unexpected shapes (n_in %d out %d ws %zu)\n", n_in, out_size, ws_size); grid = -1; return; }
        int dev = 0, cus = 0, per_cu = 0;
        (void)hipGetDevice(&dev); (void)hipDeviceGetAttribute(&cus, hipDeviceAttributeMultiprocessorCount, dev);
        if (hipFuncSetAttribute((const void*)hymba_fwd, hipFuncAttributeMaxDynamicSharedMemorySize, LDS_BYTES) != hipSuccess) { fprintf(stderr, "kernel_launch: hipFuncSetAttribute failed\n"); grid = -1; return; }
        if (hipOccupancyMaxActiveBlocksPerMultiprocessor(&per_cu, (const void*)hymba_fwd, 512, LDS_BYTES) != hipSuccess || per_cu < 1) { fprintf(stderr, "kernel_launch: occupancy query says %d\n", per_cu); per_cu = 1; }
        (void)hipGetLastError();
        grid = cus > 0 ? cus : 256;
    }
    if (grid < 0) return;
    (void)hipMemsetAsync((char*)d_ws + WS_CTL, 0, CTL_BYTES, stream);
    Params p{};
    p.x_prompt = (const float*)d_in[0]; p.x_sample = (const float*)d_in[1]; p.cache_k = (const float*)d_in[2]; p.cache_v = (const float*)d_in[3];
    p.state_conv = (const float*)d_in[4]; p.state_ssm = (const float*)d_in[5]; p.w_in = (const float*)d_in[6]; p.w_out = (const float*)d_in[7];
    p.conv_w = (const float*)d_in[8]; p.conv_b = (const float*)d_in[9]; p.dt_bias = (const float*)d_in[10]; p.a_log = (const float*)d_in[11];
    p.d_skip = (const float*)d_in[12]; p.ssm_norm = (const float*)d_in[13]; p.norm_mix = (const float*)d_in[14]; p.norm_mlp = (const float*)d_in[15];
    p.w_up = (const float*)d_in[16]; p.w_down = (const float*)d_in[17]; p.norm_final = (const float*)d_in[18];
    p.out = (float*)d_out; p.ws = (unsigned char*)d_ws;
#if HY_N_LAUNCHES == 1
    p.ph_lo = 0; p.ph_hi = 8;
    { void* args[] = {&p}; hipError_t e = hipLaunchCooperativeKernel((const void*)hymba_fwd, dim3(grid), dim3(512), args, LDS_BYTES, stream);
      if (e != hipSuccess) fprintf(stderr, "cooperative launch failed: %s (grid %d)\n", hipGetErrorString(e), grid); }
#else
    for (int ph = 0; ph < 8; ++ph) { p.ph_lo = ph; p.ph_hi = ph + 1; void* args[] = {&p};
        hipError_t e = hipLaunchCooperativeKernel((const void*)hymba_fwd, dim3(grid), dim3(512), args, LDS_BYTES, stream);
        if (e != hipSuccess) { fprintf(stderr, "cooperative launch %d failed: %s (grid %d)\n", ph, hipGetErrorString(e), grid); break; } }
#endif
}
```
